# Optimizing an MI355X kernel written in HIP

```python
import jax, jax.numpy as jnp
from jax import lax
import numpy as np

D_MODEL = 1024
BATCH = 8
SEQ = 4096
DEPTH = 2

N_MIXERS = 2
N_MEM = 256
MEM_HEADS = 4
MEM_HD = 64
SB_HEADS = 12
SB_HD = 64
SB_BLOCK = 128
HG_HEADS = 6
HG_DK = 128
HG_DV = 128
HG_CHUNK = 64
D_FF = 4 * D_MODEL
D_MIX = SB_HEADS * SB_HD + MEM_HEADS * MEM_HD
SB_PROJ = 3 * SB_HEADS * SB_HD + MEM_HEADS * MEM_HD
HG_PROJ = 2 * HG_HEADS * HG_DK + 2 * HG_HEADS * HG_DV + MEM_HEADS * MEM_HD
N_LAYERS_A = (DEPTH + N_MIXERS - 1) // N_MIXERS
N_LAYERS_B = (DEPTH + N_MIXERS - 2) // N_MIXERS
DN_ALPHA = (2 * DEPTH) ** 0.25
DN_BETA = (8 * DEPTH) ** -0.25
LN_EPS = 1e-5
RMS_EPS = 1e-6

kernel_name = "hybrid_stickbreak_hgrn2_memxattn_deepnorm"


def layer_norm(x, g, b):
    xf = x.astype(jnp.float32)
    mu = jnp.mean(xf, axis=-1, keepdims=True)
    var = jnp.mean(jnp.square(xf - mu), axis=-1, keepdims=True)
    return ((xf - mu) * lax.rsqrt(var + LN_EPS) * g + b).astype(x.dtype)


def split_heads(t, h):
    b, s, _ = t.shape
    return t.reshape(b, s, h, -1).transpose(0, 2, 1, 3)


def merge_heads(t):
    b, h, s, d = t.shape
    return t.transpose(0, 2, 1, 3).reshape(b, s, h * d)


def memory_attention(q_mem, mem, w_mem_kv):
    k, v = jnp.split(mem @ w_mem_kv, 2, axis=-1)
    q = split_heads(q_mem, MEM_HEADS)
    k = split_heads(k, MEM_HEADS)
    v = split_heads(v, MEM_HEADS)
    s = jnp.einsum('bhtd,bhmd->bhtm', q, k).astype(jnp.float32) * (MEM_HD ** -0.5)
    p = jax.nn.softmax(s, axis=-1).astype(v.dtype)
    return merge_heads(jnp.einsum('bhtm,bhmd->bhtd', p, v))


def stick_breaking_attention(q, k, v):
    seq = q.shape[2]
    scale = SB_HD ** -0.5
    outs = []
    for blk in range(seq // SB_BLOCK):
        t0 = blk * SB_BLOCK
        t1 = t0 + SB_BLOCK
        qb = q[:, :, t0:t1]
        kb = k[:, :, :t1]
        vb = v[:, :, :t1]
        z = jnp.einsum('bhtd,bhsd->bhts', qb, kb).astype(jnp.float32) * scale
        strict = jnp.arange(t1)[None, :] < jnp.arange(t0, t1)[:, None]
        log_stay = jnp.where(strict, jax.nn.log_sigmoid(-z), 0.0)
        later = lax.cumsum(log_stay, axis=3, reverse=True) - log_stay
        w = jnp.where(strict, jnp.exp(jax.nn.log_sigmoid(z) + later), 0.0)
        outs.append(jnp.einsum('bhts,bhsd->bhtd', w.astype(vb.dtype), vb))
    return jnp.concatenate(outs, axis=2)


def hgrn2_recurrence(q, k, v, log_f):
    b, h, s, dk = q.shape
    dv = v.shape[-1]
    nc = s // HG_CHUNK

    def chunks(t):
        return t.reshape(b, h, nc, HG_CHUNK, t.shape[-1]).transpose(2, 0, 1, 3, 4)

    causal = jnp.tril(jnp.ones((HG_CHUNK, HG_CHUNK), dtype=bool))[:, :, None]

    def step(state, inp):
        qc, kc, vc, gc = inp
        G = jnp.cumsum(gc.astype(jnp.float32), axis=2)
        G_last = G[:, :, -1:]
        o_inter = jnp.einsum('bhck,bhkv->bhcv', qc * jnp.exp(G), state)
        decay = jnp.exp(jnp.where(causal, G[:, :, :, None, :] - G[:, :, None, :, :], -jnp.inf))
        scores = jnp.einsum('bhtk,bhsk,bhtsk->bhts', qc, kc, decay)
        o_intra = jnp.einsum('bhts,bhsv->bhtv', scores, vc)
        k_dec = kc * jnp.exp(G_last - G)
        new_state = jnp.exp(G_last[:, :, 0])[..., None] * state + jnp.einsum('bhck,bhcv->bhkv', k_dec, vc)
        return new_state, o_inter + o_intra

    state0 = jnp.zeros((b, h, dk, dv), jnp.float32)
    _, o = lax.scan(step, state0, (chunks(q), chunks(k), chunks(v), chunks(log_f)))
    return o.transpose(1, 2, 0, 3, 4).reshape(b, h, s, dv)


def hgrn2_mixer(proj, lb, gnorm_g):
    wk = HG_HEADS * HG_DK
    wv = HG_HEADS * HG_DV
    q = proj[..., :wk]
    f_pre = proj[..., wk:2 * wk].astype(jnp.float32)
    i = proj[..., 2 * wk:2 * wk + wv]
    gate = proj[..., 2 * wk + wv:]
    log_f = jnp.logaddexp(jnp.log(lb), jnp.log1p(-lb) + jax.nn.log_sigmoid(f_pre))
    k = ((1.0 - lb) * jax.nn.sigmoid(-f_pre)).astype(q.dtype)
    o = hgrn2_recurrence(split_heads(q, HG_HEADS), split_heads(k, HG_HEADS),
                         split_heads(i, HG_HEADS), split_heads(log_f, HG_HEADS))
    of = o.astype(jnp.float32)
    of = of * lax.rsqrt(jnp.mean(jnp.square(of), axis=-1, keepdims=True) + RMS_EPS)
    o = merge_heads(of) * gnorm_g
    return (o * jax.nn.silu(gate.astype(jnp.float32))).astype(proj.dtype)


def hgrn2_lower_bounds(lower_bounds):
    p = jax.nn.softmax(lower_bounds.astype(jnp.float32), axis=0)
    return jnp.cumsum(p, axis=0) - p[0:1]


def setup_inputs(seed: int = 0) -> dict:
    key = jax.random.key(seed)
    ks = jax.random.split(key, 16)
    d_hg = HG_HEADS * HG_DK
    nrm = jax.random.normal
    return {
        "x": nrm(ks[0], (BATCH, SEQ, D_MODEL), jnp.float32),
        "mem": nrm(ks[1], (BATCH, N_MEM, D_MODEL), jnp.float32),
        "w_in_sb": nrm(ks[2], (N_LAYERS_A, D_MODEL, SB_PROJ), jnp.float32) * D_MODEL ** -0.5,
        "w_in_hg": nrm(ks[3], (N_LAYERS_B, D_MODEL, HG_PROJ), jnp.float32) * D_MODEL ** -0.5,
        "w_mem_kv": nrm(ks[4], (DEPTH, D_MODEL, 2 * MEM_HEADS * MEM_HD), jnp.float32) * D_MODEL ** -0.5,
        "lower_bounds": 1.0 + 0.1 * nrm(ks[5], (DEPTH, d_hg), jnp.float32),
        "hg_norm_g": 1.0 + 0.05 * nrm(ks[6], (N_LAYERS_B, HG_HEADS * HG_DV), jnp.float32),
        "w_out": nrm(ks[7], (DEPTH, D_MIX, D_MODEL), jnp.float32) * (D_MIX ** -0.5 * DN_BETA),
        "ln_mix_g": 1.0 + 0.05 * nrm(ks[8], (DEPTH, D_MODEL), jnp.float32),
        "ln_mix_b": 0.02 * nrm(ks[9], (DEPTH, D_MODEL), jnp.float32),
        "w_up": nrm(ks[10], (DEPTH, D_MODEL, D_FF), jnp.float32) * D_MODEL ** -0.5,
        "w_down": nrm(ks[11], (DEPTH, D_FF, D_MODEL), jnp.float32) * (D_FF ** -0.5 * DN_BETA),
        "ln_ffn_g": 1.0 + 0.05 * nrm(ks[12], (DEPTH, D_MODEL), jnp.float32),
        "ln_ffn_b": 0.02 * nrm(ks[13], (DEPTH, D_MODEL), jnp.float32),
    }


def reference(x, mem, w_in_sb, w_in_hg, w_mem_kv, lower_bounds, hg_norm_g, w_out,
              ln_mix_g, ln_mix_b, w_up, w_down, ln_ffn_g, ln_ffn_b):
    lbs = hgrn2_lower_bounds(lower_bounds)
    w_sb = SB_HEADS * SB_HD
    for layer in range(DEPTH):
        slot = layer // N_MIXERS
        if layer % N_MIXERS == 0:
            proj = x @ w_in_sb[slot]
            q = split_heads(proj[..., :w_sb], SB_HEADS)
            k = split_heads(proj[..., w_sb:2 * w_sb], SB_HEADS)
            v = split_heads(proj[..., 2 * w_sb:3 * w_sb], SB_HEADS)
            q_mem = proj[..., 3 * w_sb:]
            mix = merge_heads(stick_breaking_attention(q, k, v))
        else:
            proj = x @ w_in_hg[slot]
            split = 2 * HG_HEADS * HG_DK + 2 * HG_HEADS * HG_DV
            q_mem = proj[..., split:]
            mix = hgrn2_mixer(proj[..., :split], lbs[layer], hg_norm_g[slot])
        mem_out = memory_attention(q_mem, mem, w_mem_kv[layer])
        y = jnp.concatenate([mix, mem_out.astype(mix.dtype)], axis=-1) @ w_out[layer]
        x = layer_norm(DN_ALPHA * x + y, ln_mix_g[layer], ln_mix_b[layer])
        h = jnp.square(jax.nn.relu(x @ w_up[layer]))
        x = layer_norm(DN_ALPHA * x + h @ w_down[layer], ln_ffn_g[layer], ln_ffn_b[layer])
    return x
```

```cpp
#include <hip/hip_runtime.h>
#include <hip/hip_cooperative_groups.h>
#include <cstdio>
namespace cg = cooperative_groups;

#ifndef ONE_LAUNCH
#define ONE_LAUNCH 0
#endif

#define LAS __attribute__((address_space(3)))
typedef unsigned short bf16_t;
typedef short bf16x8 __attribute__((ext_vector_type(8)));
typedef float f32x4 __attribute__((ext_vector_type(4)));
typedef float f32x2 __attribute__((ext_vector_type(2)));
typedef unsigned u32x4 __attribute__((ext_vector_type(4)));
typedef unsigned u32x2 __attribute__((ext_vector_type(2)));

constexpr int T_TOK = 32768, SEQ = 4096, DM = 1024, DFF = 4096;
constexpr int NP0 = 2560, NP1 = 3328;
constexpr float ALPHA = 1.41421356237f, LN_EPS = 1e-5f, RMS_EPS = 1e-6f;

constexpr size_t MiB = 1u << 20;
constexpr size_t WS_CTL = 0, CTL_ZERO_BYTES = 128 * 1024;
constexpr size_t OFF_C1HG = 0, OFF_C2HG = 16384, OFF_C1UP0 = 32768, OFF_C2UP0 = 49152, OFF_C1UP1 = 65536, OFF_C2UP1 = 81920;
constexpr size_t WS_WSB = 1 * MiB, WS_WHG = 6 * MiB, WS_WKV = 13 * MiB, WS_WOUT = 15 * MiB, WS_WUP = 19 * MiB, WS_WDN = 35 * MiB;
constexpr size_t WS_MEMB = 51 * MiB, WS_MEMKV = 55 * MiB, WS_STA = 59 * MiB, WS_STB = 63 * MiB;
constexpr size_t WS_UB = 68 * MiB, WS_MIX = 132 * MiB, WS_PROJ = 196 * MiB, WS_LOGF = 404 * MiB, WS_H = 196 * MiB, WS_END = 500 * MiB;
static_assert(WS_PROJ + (size_t)T_TOK * NP1 * 2 <= WS_LOGF, "proj");
static_assert(WS_LOGF + (size_t)T_TOK * 768 * 4 <= WS_END, "logf");
static_assert(WS_H + (size_t)T_TOK * DFF * 2 <= WS_END, "h");

constexpr int LDS_BYTES = 147456;

__device__ __forceinline__ unsigned cvt_pk_bf16(float lo, float hi) { unsigned r; asm volatile("v_cvt_pk_bf16_f32 %0, %1, %2" : "=v"(r) : "v"(lo), "v"(hi)); return r; }
__device__ __forceinline__ float bf2f(bf16_t b) { return __uint_as_float(((unsigned)b) << 16); }
__device__ __forceinline__ float bflo(unsigned w) { return __uint_as_float(w << 16); }
__device__ __forceinline__ float bfhi(unsigned w) { return __uint_as_float(w & 0xffff0000u); }
__device__ __forceinline__ bf16_t f2bf(float f) { return (bf16_t)(cvt_pk_bf16(f, 0.f) & 0xffffu); }
__device__ __forceinline__ float wave_sum(float v) {
#pragma unroll
    for (int o = 1; o < 64; o <<= 1) v += __shfl_xor(v, o);
    return v;
}

namespace pg8 {
constexpr int BM = 256, BK = 64, HALF = 128, HTB = HALF * BK * 2, STAGE_BYTES = 8 * HTB, NXCD = 8, WGM = 8;
__host__ __device__ __forceinline__ int lds_byte(int r, int c) { const int st = (r >> 4) * 2 + (c >> 5), rr = r & 15, cc = c & 31, ob = rr * 64 + cc * 2; return st * 1024 + (ob ^ (((ob >> 9) & 1) << 5)); }
__host__ __device__ __forceinline__ void stage_rc(int b, int& R, int& C) { const int st = b / 1024, sb = b % 1024, swz = sb ^ (((sb >> 9) & 1) << 5); R = (st >> 1) * 16 + swz / 64; C = (st & 1) * 32 + (swz % 64) / 2; }
__host__ __device__ __forceinline__ int perm32(int rho) { const int n = rho >> 4, i = rho & 15; return 8 * (i >> 2) + 4 * n + (i & 3); }
struct Unit { int pm, pn; };
struct Gemm { const bf16_t* A; const bf16_t* Bt; int M, N, K; };
struct StaticOrder {
    int nM, nN, nwg, G, c;
    __host__ __device__ void init(int M, int N, int G_, int c_) { nM = M / BM; nN = N / BM; nwg = nM * nN; G = G_; c = c_; }
    __host__ __device__ bool next(int i, Unit& u) const {
        const long L = (long)i * G + c; if (L >= nwg) return false;
        int wgid = (int)L; { const int q = nwg / NXCD, r = nwg % NXCD, xcd = wgid % NXCD, off = wgid / NXCD; wgid = (xcd < r ? xcd * (q + 1) : r * (q + 1) + (xcd - r) * q) + off; }
        const int nig = WGM * nN, gid = wgid / nig, fm = gid * WGM, gsz = (nM - fm) < WGM ? (nM - fm) : WGM;
        u.pm = fm + ((wgid % nig) % gsz); u.pn = (wgid % nig) / gsz; return true;
    }
};

template <class Epi, class Sched>
__device__ __forceinline__ void gemm_phase(LAS unsigned char* lds, const Gemm g, const Sched& S, const Epi& E) {
    const int tid = threadIdx.x, wid = __builtin_amdgcn_readfirstlane(tid >> 6), lane = tid & 63, wr = wid >> 2, wc = wid & 3, fr = lane & 15, fq = lane >> 4;
    const int K = g.K, nt = K / BK;
    unsigned voffA[2], voffB[2];
#pragma unroll
    for (int i = 0; i < 2; ++i) { int R, C; stage_rc(tid * 16 + i * 8192, R, C); const int Rb = Epi::PERM ? ((R & ~31) + perm32(R & 31)) : R;
        voffA[i] = (unsigned)(R * K + C) * 2u; voffB[i] = (unsigned)(Rb * K + C) * 2u; }
    const size_t kstep = (size_t)(BK * 2);
    const size_t hstep = (size_t)HALF * K * 2;
    const size_t tstep = 2 * hstep;
    const unsigned ldsw = (unsigned)wid * 1024u;
    const int aoff = lds_byte(wr * 64 + fr, fq * 8), boff = lds_byte(wc * 32 + fr, fq * 8);
#define PG8_SA(b, h) (((b) * 2 + (h)) * HTB)
#define PG8_SB(b, h) ((4 + (b) * 2 + (h)) * HTB)
#define PG8_STAGE(bufoff, gbase, voff) do { _Pragma("unroll") for (int _i = 0; _i < 2; ++_i) \
        __builtin_amdgcn_global_load_lds((const unsigned*)((const char*)(gbase) + (voff)[_i]), (LAS unsigned*)(lds + (bufoff) + ldsw + _i * 8192), 16, 0, 0); } while (0)
#define PG8_LDA(dst, b, h) do { _Pragma("unroll") for (int m = 0; m < 4; ++m) _Pragma("unroll") for (int k = 0; k < 2; ++k) dst[m][k] = *(const LAS bf16x8*)(lds + PG8_SA(b, h) + aoff + m * 2048 + k * 1024); } while (0)
#define PG8_LDB(dst, b, h) do { _Pragma("unroll") for (int n = 0; n < 2; ++n) _Pragma("unroll") for (int k = 0; k < 2; ++k) dst[n][k] = *(const LAS bf16x8*)(lds + PG8_SB(b, h) + boff + n * 2048 + k * 1024); } while (0)
#define PG8_MMA(ai, bj, At, Bt) do { __builtin_amdgcn_s_setprio(1); _Pragma("unroll") for (int m = 0; m < 4; ++m) _Pragma("unroll") for (int n = 0; n < 2; ++n) _Pragma("unroll") for (int k = 0; k < 2; ++k) \
        acc[ai][bj][m][n] = __builtin_amdgcn_mfma_f32_16x16x32_bf16(Bt[n][k], At[m][k], acc[ai][bj][m][n], 0, 0, 0); __builtin_amdgcn_s_setprio(0); } while (0)
#define PG8_WAIT_V(n) asm volatile("s_waitcnt vmcnt(" #n ")" ::: "memory")
#define PG8_WAIT_L(n) asm volatile("s_waitcnt lgkmcnt(" #n ")" ::: "memory")
#define PG8_BAR __builtin_amdgcn_s_barrier()
#define PG8_SCHED __builtin_amdgcn_sched_barrier(0)
    Unit cur, nxt; int ui = 0;
    if (!S.next(0, cur)) return;
    f32x4 acc[2][2][4][2];
#pragma unroll
    for (int a = 0; a < 2; ++a)
#pragma unroll
        for (int b = 0; b < 2; ++b)
#pragma unroll
            for (int m = 0; m < 4; ++m)
#pragma unroll
                for (int n = 0; n < 2; ++n) acc[a][b][m][n] = (f32x4){0.f, 0.f, 0.f, 0.f};
    bf16x8 At[4][2], B0[2][2], B1[2][2];
    const char* cA = (const char*)g.A + (size_t)cur.pm * tstep; const char* cB = (const char*)g.Bt + (size_t)cur.pn * tstep;
    PG8_STAGE(PG8_SB(0, 0), cB, voffB); PG8_STAGE(PG8_SA(0, 0), cA, voffA); PG8_STAGE(PG8_SB(0, 1), cB + hstep, voffB); PG8_STAGE(PG8_SA(0, 1), cA + hstep, voffA);
    if (wr == 1) PG8_BAR;
    PG8_WAIT_V(4); PG8_BAR;
    PG8_STAGE(PG8_SB(1, 0), cB + kstep, voffB); PG8_STAGE(PG8_SA(1, 0), cA + kstep, voffA); PG8_STAGE(PG8_SB(1, 1), cB + hstep + kstep, voffB);
    PG8_WAIT_V(6); PG8_BAR;
    for (;;) {
        const bool has_next = S.next(ui + 1, nxt);
        const char* nA = has_next ? (const char*)g.A + (size_t)nxt.pm * tstep : cA; const char* nB = has_next ? (const char*)g.Bt + (size_t)nxt.pn * tstep : cB;
        for (int t = 0; t < nt; t += 2) {
            const bool last = (t == nt - 2);
            const char* a1 = cA + (size_t)(t + 1) * kstep;
            const char* a2 = last ? nA : cA + (size_t)(t + 2) * kstep; const char* b2 = last ? nB : cB + (size_t)(t + 2) * kstep;
            const char* a3 = a2 + kstep; const char* b3 = b2 + kstep;
            PG8_LDB(B0, 0, 0); PG8_SCHED; PG8_LDA(At, 0, 0); PG8_STAGE(PG8_SA(1, 1), a1 + hstep, voffA);
            PG8_WAIT_L(8); PG8_BAR; PG8_WAIT_L(0); PG8_MMA(0, 0, At, B0); PG8_BAR; PG8_SCHED;
            PG8_LDB(B1, 0, 1); PG8_STAGE(PG8_SB(0, 0), b2, voffB);
            PG8_BAR; PG8_WAIT_L(0); PG8_MMA(0, 1, At, B1); PG8_BAR;
            PG8_LDA(At, 0, 1); PG8_STAGE(PG8_SA(0, 0), a2, voffA);
            PG8_BAR; PG8_WAIT_L(0); PG8_MMA(1, 0, At, B0); PG8_BAR; PG8_SCHED;
            PG8_STAGE(PG8_SB(0, 1), b2 + hstep, voffB);
            PG8_WAIT_V(6); PG8_BAR; PG8_MMA(1, 1, At, B1); PG8_BAR;
            PG8_LDB(B0, 1, 0); PG8_SCHED; PG8_LDA(At, 1, 0); PG8_STAGE(PG8_SA(0, 1), a2 + hstep, voffA);
            PG8_WAIT_L(8); PG8_BAR; PG8_WAIT_L(0); PG8_MMA(0, 0, At, B0); PG8_BAR; PG8_SCHED;
            PG8_LDB(B1, 1, 1); PG8_STAGE(PG8_SB(1, 0), b3, voffB);
            PG8_BAR; PG8_WAIT_L(0); PG8_MMA(0, 1, At, B1); PG8_BAR;
            PG8_LDA(At, 1, 1); PG8_STAGE(PG8_SA(1, 0), a3, voffA);
            PG8_BAR; PG8_WAIT_L(0); PG8_MMA(1, 0, At, B0); PG8_BAR; PG8_SCHED;
            PG8_STAGE(PG8_SB(1, 1), b3 + hstep, voffB);
            PG8_WAIT_V(6); PG8_BAR; PG8_MMA(1, 1, At, B1); PG8_BAR;
        }
        E(acc, cur, wr, wc, fr, fq);
        if (!has_next) break;
#pragma unroll
        for (int a = 0; a < 2; ++a)
#pragma unroll
            for (int b = 0; b < 2; ++b)
#pragma unroll
                for (int m = 0; m < 4; ++m)
#pragma unroll
                    for (int n = 0; n < 2; ++n) acc[a][b][m][n] = (f32x4){0.f, 0.f, 0.f, 0.f};
        cur = nxt; cA = nA; cB = nB; ++ui;
    }
    PG8_WAIT_V(0);
    if (wr == 0) PG8_BAR;
    PG8_BAR;
#undef PG8_SA
#undef PG8_SB
#undef PG8_STAGE
#undef PG8_LDA
#undef PG8_LDB
#undef PG8_MMA
#undef PG8_WAIT_V
#undef PG8_WAIT_L
#undef PG8_BAR
#undef PG8_SCHED
}
}

typedef f32x4 AccT[2][2][4][2];

__device__ __forceinline__ void row_stats(const float* st, int row, int fq, float& mean, float& rstd) {
    const f32x4* p = (const f32x4*)(st + (size_t)row * 32 + fq * 8);
    const f32x4 a = p[0], b = p[1];
    float s1 = (a[0] + a[2]) + (b[0] + b[2]), s2 = (a[1] + a[3]) + (b[1] + b[3]);
    s1 += __shfl_xor(s1, 16); s2 += __shfl_xor(s2, 16); s1 += __shfl_xor(s1, 32); s2 += __shfl_xor(s2, 32);
    mean = s1 * (1.f / DM);
    const float var = fmaxf(s2 * (1.f / DM) - mean * mean, 0.f);
    rstd = 1.0f / sqrtf(var + LN_EPS);
}

struct EpiBf16Plain {
    static constexpr bool PERM = true;
    bf16_t* O; int ldc;
    __device__ __forceinline__ void operator()(const AccT& acc, const pg8::Unit& u, int wr, int wc, int fr, int fq) const {
        const int row0 = u.pm * 256 + wr * 64 + fr, col0 = u.pn * 256 + wc * 32 + 8 * fq;
#pragma unroll
        for (int ai = 0; ai < 2; ++ai)
#pragma unroll
            for (int m = 0; m < 4; ++m) { bf16_t* rowp = O + (size_t)(row0 + ai * 128 + m * 16) * ldc + col0;
#pragma unroll
                for (int bj = 0; bj < 2; ++bj) { const f32x4 v0 = acc[ai][bj][m][0], v1 = acc[ai][bj][m][1];
                    u32x4 w; w.x = cvt_pk_bf16(v0[0], v0[1]); w.y = cvt_pk_bf16(v0[2], v0[3]); w.z = cvt_pk_bf16(v1[0], v1[1]); w.w = cvt_pk_bf16(v1[2], v1[3]);
                    *(u32x4*)(rowp + bj * 128) = w; } }
    }
};

template <int MODE> struct EpiResid {
    static constexpr bool PERM = false;
    const float* rin; float* uout; bf16_t* ub; const float* stats_in; float* stats_out; const float* g; const float* b;
    __device__ __forceinline__ void operator()(const AccT& acc, const pg8::Unit& u, int wr, int wc, int fr, int fq) const {
        const int row0 = u.pm * 256 + wr * 64 + fr, col0 = u.pn * 256 + wc * 32 + 4 * fq;
        f32x4 gv[2][2], bv[2][2];
        if (MODE == 1) {
#pragma unroll
            for (int bj = 0; bj < 2; ++bj)
#pragma unroll
                for (int n = 0; n < 2; ++n) { gv[bj][n] = *(const f32x4*)(g + col0 + bj * 128 + n * 16); bv[bj][n] = *(const f32x4*)(b + col0 + bj * 128 + n * 16); }
        }
#pragma unroll
        for (int ai = 0; ai < 2; ++ai)
#pragma unroll
            for (int m = 0; m < 4; ++m) {
                const int row = row0 + ai * 128 + m * 16;
                float mean = 0.f, rstd = 1.f;
                if (MODE == 1) row_stats(stats_in, row, fq, mean, rstd);
                float s1 = 0.f, s2 = 0.f;
#pragma unroll
                for (int bj = 0; bj < 2; ++bj)
#pragma unroll
                    for (int n = 0; n < 2; ++n) {
                        const size_t off = (size_t)row * DM + col0 + bj * 128 + n * 16;
                        f32x4 rv = *(const f32x4*)(rin + off);
                        if (MODE == 1) rv = (rv - mean) * rstd * gv[bj][n] + bv[bj][n];
                        const f32x4 o = rv * ALPHA + acc[ai][bj][m][n];
                        *(f32x4*)(uout + off) = o;
                        if (ub) { u32x2 w; w.x = cvt_pk_bf16(o[0], o[1]); w.y = cvt_pk_bf16(o[2], o[3]); *(u32x2*)(ub + off) = w; }
                        s1 += (o[0] + o[1]) + (o[2] + o[3]); s2 += (o[0] * o[0] + o[1] * o[1]) + (o[2] * o[2] + o[3] * o[3]);
                    }
                s1 += __shfl_xor(s1, 16); s2 += __shfl_xor(s2, 16); s1 += __shfl_xor(s1, 32); s2 += __shfl_xor(s2, 32);
                if (fq == 0) *(f32x2*)(stats_out + (size_t)row * 32 + (u.pn * 4 + wc) * 2) = (f32x2){s1, s2};
            }
    }
};

struct EpiUp {
    static constexpr bool PERM = true;
    bf16_t* O; const float* stats_in; const float* c1; const float* c2;
    __device__ __forceinline__ void operator()(const AccT& acc, const pg8::Unit& u, int wr, int wc, int fr, int fq) const {
        const int row0 = u.pm * 256 + wr * 64 + fr, col0 = u.pn * 256 + wc * 32 + 8 * fq;
        f32x4 c1v[2][2], c2v[2][2];
#pragma unroll
        for (int bj = 0; bj < 2; ++bj)
#pragma unroll
            for (int n = 0; n < 2; ++n) { c1v[bj][n] = *(const f32x4*)(c1 + col0 + bj * 128 + 4 * n); c2v[bj][n] = *(const f32x4*)(c2 + col0 + bj * 128 + 4 * n); }
#pragma unroll
        for (int ai = 0; ai < 2; ++ai)
#pragma unroll
            for (int m = 0; m < 4; ++m) {
                const int row = row0 + ai * 128 + m * 16;
                float mean, rstd; row_stats(stats_in, row, fq, mean, rstd);
                bf16_t* rowp = O + (size_t)row * DFF + col0;
#pragma unroll
                for (int bj = 0; bj < 2; ++bj) {
                    f32x4 v0 = (acc[ai][bj][m][0] - mean * c1v[bj][0]) * rstd + c2v[bj][0];
                    f32x4 v1 = (acc[ai][bj][m][1] - mean * c1v[bj][1]) * rstd + c2v[bj][1];
#pragma unroll
                    for (int j = 0; j < 4; ++j) { const float a = fmaxf(v0[j], 0.f), c = fmaxf(v1[j], 0.f); v0[j] = a * a; v1[j] = c * c; }
                    u32x4 w; w.x = cvt_pk_bf16(v0[0], v0[1]); w.y = cvt_pk_bf16(v0[2], v0[3]); w.z = cvt_pk_bf16(v1[0], v1[1]); w.w = cvt_pk_bf16(v1[2], v1[3]);
                    *(u32x4*)(rowp + bj * 128) = w; }
            }
    }
};

struct EpiProj1 {
    static constexpr bool PERM = true;
    bf16_t* O; float* logf; const float* stats_in; const float* c1; const float* c2; const float* lbin;
    __device__ __forceinline__ void operator()(const AccT& acc, const pg8::Unit& u, int wr, int wc, int fr, int fq) const {
        const int row0 = u.pm * 256 + wr * 64 + fr, col0 = u.pn * 256 + wc * 32 + 8 * fq;
        const int kind = u.pn / 3;
        f32x4 c1v[2][2], c2v[2][2], lbv[2][2];
#pragma unroll
        for (int bj = 0; bj < 2; ++bj)
#pragma unroll
            for (int n = 0; n < 2; ++n) { c1v[bj][n] = *(const f32x4*)(c1 + col0 + bj * 128 + 4 * n); c2v[bj][n] = *(const f32x4*)(c2 + col0 + bj * 128 + 4 * n); lbv[bj][n] = (f32x4){0.f, 0.f, 0.f, 0.f}; }
        if (kind == 1) {
#pragma unroll
            for (int bj = 0; bj < 2; ++bj)
#pragma unroll
                for (int n = 0; n < 2; ++n) {
                    const int j0 = col0 - 768 + bj * 128 + 4 * n;
                    const f32x4 l0 = *(const f32x4*)(lbin + j0), l1 = *(const f32x4*)(lbin + 768 + j0);
#pragma unroll
                    for (int j = 0; j < 4; ++j) { const float mx = fmaxf(l0[j], l1[j]), e0 = __expf(l0[j] - mx), e1 = __expf(l1[j] - mx), s = e0 + e1, p0 = e0 / s, p1 = e1 / s; lbv[bj][n][j] = (p0 + p1) - p0; }
                }
        }
#pragma unroll
        for (int ai = 0; ai < 2; ++ai)
#pragma unroll
            for (int m = 0; m < 4; ++m) {
                const int row = row0 + ai * 128 + m * 16;
                float mean, rstd; row_stats(stats_in, row, fq, mean, rstd);
                bf16_t* rowp = O + (size_t)row * NP1 + col0;
#pragma unroll
                for (int bj = 0; bj < 2; ++bj) {
                    f32x4 v[2];
                    v[0] = (acc[ai][bj][m][0] - mean * c1v[bj][0]) * rstd + c2v[bj][0];
                    v[1] = (acc[ai][bj][m][1] - mean * c1v[bj][1]) * rstd + c2v[bj][1];
                    if (kind == 1) {
                        float* lp = logf + (size_t)row * 768 + (col0 - 768) + bj * 128;
#pragma unroll
                        for (int n = 0; n < 2; ++n) { f32x4 lf;
#pragma unroll
                            for (int j = 0; j < 4; ++j) { const float z = fminf(fmaxf(v[n][j], -80.f), 80.f), t = __expf(-z), sg = 1.0f / (1.0f + t), lb = lbv[bj][n][j];
                                lf[j] = __logf(lb + (1.0f - lb) * sg); v[n][j] = (1.0f - lb) * (t * sg); }
                            *(f32x4*)(lp + 4 * n) = lf; }
                    } else if (kind == 3) {
#pragma unroll
                        for (int n = 0; n < 2; ++n)
#pragma unroll
                            for (int j = 0; j < 4; ++j) { const float z = fminf(fmaxf(v[n][j], -80.f), 80.f); v[n][j] = v[n][j] / (1.0f + __expf(-z)); }
                    }
                    u32x4 w; w.x = cvt_pk_bf16(v[0][0], v[0][1]); w.y = cvt_pk_bf16(v[0][2], v[0][3]); w.z = cvt_pk_bf16(v[1][0], v[1][1]); w.w = cvt_pk_bf16(v[1][2], v[1][3]);
                    *(u32x4*)(rowp + bj * 128) = w; }
            }
    }
};

#define LDS_WAIT() asm volatile("s_waitcnt lgkmcnt(0)" ::: "memory")
__device__ __forceinline__ void p0_transpose_item(const float* W, int K, int N, bf16_t* WT, LAS float* scr, int item, int lane,
                                                  const float* g, const float* b, float* c1, float* c2) {
    const int nblk = N / 32, kb = item / nblk, nb = item % nblk, k0 = 64 * kb, n0 = 32 * nb;
#pragma unroll 8
    for (int i = 0; i < 32; ++i) { const int kk = 2 * i + (lane >> 5); scr[kk * 33 + (lane & 31)] = W[(size_t)(k0 + kk) * N + n0 + (lane & 31)]; }
    LDS_WAIT(); asm volatile("" ::: "memory");
    const int c = lane & 7;
    float gk[8], bk[8];
#pragma unroll
    for (int e = 0; e < 8; ++e) { gk[e] = g ? g[k0 + 8 * c + e] : 1.f; bk[e] = g ? b[k0 + 8 * c + e] : 0.f; }
#pragma unroll
    for (int j = 0; j < 4; ++j) { const int n = (lane >> 3) + 8 * j; const LAS float* s = scr + (8 * c) * 33 + n;
        float w[8], p2 = 0.f;
#pragma unroll
        for (int e = 0; e < 8; ++e) { const float x = s[e * 33]; w[e] = x * gk[e]; p2 += bk[e] * x; }
        u32x4 o; o.x = cvt_pk_bf16(w[0], w[1]); o.y = cvt_pk_bf16(w[2], w[3]); o.z = cvt_pk_bf16(w[4], w[5]); o.w = cvt_pk_bf16(w[6], w[7]);
        *(u32x4*)(WT + (size_t)(n0 + n) * K + k0 + 8 * c) = o;
        if (g) {
            float p1 = ((bflo(o.x) + bfhi(o.x)) + (bflo(o.y) + bfhi(o.y))) + ((bflo(o.z) + bfhi(o.z)) + (bflo(o.w) + bfhi(o.w)));
            p1 += __shfl_xor(p1, 1); p2 += __shfl_xor(p2, 1); p1 += __shfl_xor(p1, 2); p2 += __shfl_xor(p2, 2); p1 += __shfl_xor(p1, 4); p2 += __shfl_xor(p2, 4);
            if (c == 0) { atomicAdd(c1 + n0 + n, p1); atomicAdd(c2 + n0 + n, p2); }
        }
    }
    LDS_WAIT(); asm volatile("" ::: "memory");
}
__device__ __forceinline__ void row_to_bf16(const float* xrow, bf16_t* orow, int lane) {
    const f32x4* xr = (const f32x4*)xrow + lane; u32x2* o8 = (u32x2*)orow + lane;
#pragma unroll
    for (int j = 0; j < 4; ++j) { const f32x4 v = xr[64 * j]; u32x2 w; w.x = cvt_pk_bf16(v[0], v[1]); w.y = cvt_pk_bf16(v[2], v[3]); o8[64 * j] = w; }
}

struct Args { const float* in[14]; float* out; unsigned char* ws; int ph_lo, ph_hi; };

__device__ __forceinline__ void load_row64(const bf16_t* p, float* f) {
#pragma unroll
    for (int c = 0; c < 8; ++c) { const u32x4 w = *(const u32x4*)(p + 8 * c);
        f[8 * c + 0] = bflo(w.x); f[8 * c + 1] = bfhi(w.x); f[8 * c + 2] = bflo(w.y); f[8 * c + 3] = bfhi(w.y);
        f[8 * c + 4] = bflo(w.z); f[8 * c + 5] = bfhi(w.z); f[8 * c + 6] = bflo(w.w); f[8 * c + 7] = bfhi(w.w); }
}
__device__ __forceinline__ float dot_row64(const bf16_t* p, const float* q) {
    float s0 = 0.f, s1 = 0.f;
#pragma unroll
    for (int c = 0; c < 8; ++c) { const u32x4 w = *(const u32x4*)(p + 8 * c);
        s0 += q[8 * c + 0] * bflo(w.x); s1 += q[8 * c + 1] * bfhi(w.x); s0 += q[8 * c + 2] * bflo(w.y); s1 += q[8 * c + 3] * bfhi(w.y);
        s0 += q[8 * c + 4] * bflo(w.z); s1 += q[8 * c + 5] * bfhi(w.z); s0 += q[8 * c + 6] * bflo(w.w); s1 += q[8 * c + 7] * bfhi(w.w); }
    return s0 + s1;
}
__device__ __forceinline__ void axpy_row64(const bf16_t* p, float wgt, float* o) {
#pragma unroll
    for (int c = 0; c < 8; ++c) { const u32x4 w = *(const u32x4*)(p + 8 * c);
        o[8 * c + 0] += wgt * bflo(w.x); o[8 * c + 1] += wgt * bfhi(w.x); o[8 * c + 2] += wgt * bflo(w.y); o[8 * c + 3] += wgt * bfhi(w.y);
        o[8 * c + 4] += wgt * bflo(w.z); o[8 * c + 5] += wgt * bfhi(w.z); o[8 * c + 6] += wgt * bflo(w.w); o[8 * c + 7] += wgt * bfhi(w.w); }
}
__device__ __forceinline__ void store_row64(bf16_t* p, const float* o, float sc) {
#pragma unroll
    for (int c = 0; c < 8; ++c) { u32x4 w; w.x = cvt_pk_bf16(o[8 * c] * sc, o[8 * c + 1] * sc); w.y = cvt_pk_bf16(o[8 * c + 2] * sc, o[8 * c + 3] * sc);
        w.z = cvt_pk_bf16(o[8 * c + 4] * sc, o[8 * c + 5] * sc); w.w = cvt_pk_bf16(o[8 * c + 6] * sc, o[8 * c + 7] * sc); *(u32x4*)(p + 8 * c) = w; }
}
__device__ __forceinline__ void naive_sb_attn(const bf16_t* proj, bf16_t* mix, int gtid, int nthr) {
    for (int it = gtid; it < T_TOK * 12; it += nthr) {
        const int h = it / T_TOK, tok = it - h * T_TOK, t = tok & (SEQ - 1), brow = tok - t;
        float q[64], o[64];
        load_row64(proj + (size_t)tok * NP0 + h * 64, q);
#pragma unroll
        for (int d = 0; d < 64; ++d) o[d] = 0.f;
        float P = 1.f;
        for (int s = t - 1; s >= 0; --s) {
            const bf16_t* kp = proj + (size_t)(brow + s) * NP0 + 768 + h * 64;
            const float z = fminf(dot_row64(kp, q) * 0.125f, 80.f);
            const float e = __expf(z), a = 1.0f / (1.0f + e), beta = e * a, w = beta * P;
            P *= a;
            axpy_row64(kp + 768, w, o);
            if (P < 1e-30f) break;
        }
        store_row64(mix + (size_t)tok * DM + h * 64, o, 1.f);
    }
}
__device__ __forceinline__ void naive_mem_attn(const bf16_t* proj, int ldp, int qoff, const bf16_t* kv, bf16_t* mix, int gtid, int nthr) {
    for (int it = gtid; it < T_TOK * 4; it += nthr) {
        const int hm = it / T_TOK, tok = it - hm * T_TOK, bb = tok / SEQ;
        float q[64], o[64];
        load_row64(proj + (size_t)tok * ldp + qoff + hm * 64, q);
        const bf16_t* kb = kv + (size_t)bb * 256 * 1024 + hm * 64;
        float mx = -3.0e38f;
        for (int j = 0; j < 256; ++j) mx = fmaxf(mx, dot_row64(kb + (size_t)j * 1024, q) * 0.125f);
#pragma unroll
        for (int d = 0; d < 64; ++d) o[d] = 0.f;
        float l = 0.f;
        for (int j = 0; j < 256; ++j) { const float p = __expf(dot_row64(kb + (size_t)j * 1024, q) * 0.125f - mx); l += p; axpy_row64(kb + (size_t)j * 1024 + 256, p, o); }
        store_row64(mix + (size_t)tok * DM + 768 + hm * 64, o, 1.0f / l);
    }
}
__device__ __forceinline__ void naive_hgrn(LAS unsigned char* lds, const bf16_t* proj, const float* logf, const float* gn, bf16_t* mix, int G) {
    LAS float* qs = (LAS float*)lds; LAS float* ks = qs + 1024; LAS float* fs = ks + 1024; LAS float* vs = fs + 1024; LAS float* red = vs + 1024;
    const int tid = threadIdx.x, dv = tid & 127, kg = tid >> 7, wave = tid >> 6, lane = tid & 63;
    for (int unit = blockIdx.x; unit < 48; unit += G) {
        const int bb = unit / 6, h = unit % 6; const size_t base = (size_t)bb * SEQ;
        const f32x2 g2 = *(const f32x2*)(gn + h * 128 + 2 * lane);
        float S[32];
#pragma unroll
        for (int i = 0; i < 32; ++i) S[i] = 0.f;
        for (int tb = 0; tb < SEQ / 8; ++tb) {
#pragma unroll
            for (int r = 0; r < 2; ++r) { const int tt = kg + 4 * r; const size_t row = base + tb * 8 + tt; const bf16_t* pr = proj + row * NP1 + h * 128 + dv;
                qs[tt * 128 + dv] = bf2f(pr[0]); ks[tt * 128 + dv] = bf2f(pr[768]); vs[tt * 128 + dv] = bf2f(pr[1536]); fs[tt * 128 + dv] = __expf(logf[row * 768 + h * 128 + dv]); }
            __syncthreads();
#pragma unroll 1
            for (int tt = 0; tt < 8; ++tt) { const float v = vs[tt * 128 + dv]; float part = 0.f;
#pragma unroll
                for (int i = 0; i < 32; ++i) { const int kk = kg * 32 + i; S[i] = fs[tt * 128 + kk] * S[i] + ks[tt * 128 + kk] * v; part += S[i] * qs[tt * 128 + kk]; }
                red[(tt * 4 + kg) * 128 + dv] = part; }
            __syncthreads();
            { const int tt = wave; const size_t row = base + tb * 8 + tt; const int d2 = 2 * lane;
              const float o0 = (red[(tt * 4 + 0) * 128 + d2] + red[(tt * 4 + 1) * 128 + d2]) + (red[(tt * 4 + 2) * 128 + d2] + red[(tt * 4 + 3) * 128 + d2]);
              const float o1 = (red[(tt * 4 + 0) * 128 + d2 + 1] + red[(tt * 4 + 1) * 128 + d2 + 1]) + (red[(tt * 4 + 2) * 128 + d2 + 1] + red[(tt * 4 + 3) * 128 + d2 + 1]);
              const float ss = wave_sum(o0 * o0 + o1 * o1), r = 1.0f / sqrtf(ss * (1.f / 128.f) + RMS_EPS);
              const unsigned gw = *(const unsigned*)(proj + row * NP1 + 2304 + h * 128 + d2);
              *(unsigned*)(mix + row * DM + h * 128 + d2) = cvt_pk_bf16(o0 * r * g2[0] * bflo(gw), o1 * r * g2[1] * bfhi(gw)); }
        }
        __syncthreads();
    }
}

__global__ void __launch_bounds__(512, 2) fwd_kernel(Args args) {
    extern __shared__ __attribute__((aligned(16))) unsigned char lds_raw[];
    LAS unsigned char* lds = (LAS unsigned char*)lds_raw;
    cg::grid_group grid = cg::this_grid();
    const int tid = threadIdx.x, lane = tid & 63, wave = __builtin_amdgcn_readfirstlane(tid >> 6);
    const int G = gridDim.x, bx = blockIdx.x;
    unsigned char* ws = args.ws;
    const float* x = args.in[0]; const float* mem = args.in[1]; const float* w_in_sb = args.in[2]; const float* w_in_hg = args.in[3]; const float* w_mem_kv = args.in[4];
    const float* lower_bounds = args.in[5]; const float* hg_norm_g = args.in[6]; const float* w_out = args.in[7]; const float* ln_mix_g = args.in[8]; const float* ln_mix_b = args.in[9];
    const float* w_up = args.in[10]; const float* w_down = args.in[11]; const float* ln_ffn_g = args.in[12]; const float* ln_ffn_b = args.in[13];
    float* out = args.out;
    bf16_t* WSB = (bf16_t*)(ws + WS_WSB); bf16_t* WHG = (bf16_t*)(ws + WS_WHG); bf16_t* WKV = (bf16_t*)(ws + WS_WKV); bf16_t* WOUT = (bf16_t*)(ws + WS_WOUT);
    bf16_t* WUP = (bf16_t*)(ws + WS_WUP); bf16_t* WDN = (bf16_t*)(ws + WS_WDN); bf16_t* MEMB = (bf16_t*)(ws + WS_MEMB); bf16_t* MEMKV = (bf16_t*)(ws + WS_MEMKV);
    float* STA = (float*)(ws + WS_STA); float* STB = (float*)(ws + WS_STB);
    bf16_t* UB = (bf16_t*)(ws + WS_UB); bf16_t* MIX = (bf16_t*)(ws + WS_MIX); bf16_t* PROJ = (bf16_t*)(ws + WS_PROJ); float* LOGF = (float*)(ws + WS_LOGF); bf16_t* HB = (bf16_t*)(ws + WS_H);
    float* C1HG = (float*)(ws + OFF_C1HG); float* C2HG = (float*)(ws + OFF_C2HG); float* C1UP0 = (float*)(ws + OFF_C1UP0); float* C2UP0 = (float*)(ws + OFF_C2UP0);
    float* C1UP1 = (float*)(ws + OFF_C1UP1); float* C2UP1 = (float*)(ws + OFF_C2UP1);
    const int lo = args.ph_lo, hi = args.ph_hi;
#define IN(k) (lo <= (k) && (k) < hi)
#define SEAM(k) do { if (IN(k) && IN((k) + 1)) grid.sync(); } while (0)
    const int gtid = bx * 512 + tid, nthr = G * 512;

    if (IN(0)) {
        LAS float* scr = (LAS float*)(lds + wave * 16384);
        const int gw = bx * 8 + wave, NGW = G * 8;
        constexpr int I_SB = 16 * (NP0 / 32), I_HG = 16 * (NP1 / 32), I_KV = 16 * (512 / 32), I_OUT = 16 * (1024 / 32), I_UP = 16 * (4096 / 32), I_DN = 64 * (1024 / 32);
        constexpr int NITEMS = I_SB + I_HG + 2 * I_KV + 2 * I_OUT + 2 * I_UP + 2 * I_DN;
        for (int it = gw; it < NITEMS; it += NGW) {
            int r = it;
            if (r < I_SB) { p0_transpose_item(w_in_sb, 1024, NP0, WSB, scr, r, lane, nullptr, nullptr, nullptr, nullptr); continue; } r -= I_SB;
            if (r < I_HG) { p0_transpose_item(w_in_hg, 1024, NP1, WHG, scr, r, lane, ln_ffn_g, ln_ffn_b, C1HG, C2HG); continue; } r -= I_HG;
            if (r < I_KV) { p0_transpose_item(w_mem_kv, 1024, 512, WKV, scr, r, lane, nullptr, nullptr, nullptr, nullptr); continue; } r -= I_KV;
            if (r < I_KV) { p0_transpose_item(w_mem_kv + 1024 * 512, 1024, 512, WKV + 512 * 1024, scr, r, lane, nullptr, nullptr, nullptr, nullptr); continue; } r -= I_KV;
            if (r < I_OUT) { p0_transpose_item(w_out, 1024, 1024, WOUT, scr, r, lane, nullptr, nullptr, nullptr, nullptr); continue; } r -= I_OUT;
            if (r < I_OUT) { p0_transpose_item(w_out + 1024 * 1024, 1024, 1024, WOUT + 1024 * 1024, scr, r, lane, nullptr, nullptr, nullptr, nullptr); continue; } r -= I_OUT;
            if (r < I_UP) { p0_transpose_item(w_up, 1024, 4096, WUP, scr, r, lane, ln_mix_g, ln_mix_b, C1UP0, C2UP0); continue; } r -= I_UP;
            if (r < I_UP) { p0_transpose_item(w_up + 1024 * 4096, 1024, 4096, WUP + 4096 * 1024, scr, r, lane, ln_mix_g + 1024, ln_mix_b + 1024, C1UP1, C2UP1); continue; } r -= I_UP;
            if (r < I_DN) { p0_transpose_item(w_down, 4096, 1024, WDN, scr, r, lane, nullptr, nullptr, nullptr, nullptr); continue; } r -= I_DN;
            p0_transpose_item(w_down + 4096 * 1024, 4096, 1024, WDN + 1024 * 4096, scr, r, lane, nullptr, nullptr, nullptr, nullptr);
        }
        for (int m = gw; m < T_TOK; m += NGW) row_to_bf16(x + (size_t)m * DM, UB + (size_t)m * DM, lane);
        for (int m = gw; m < 2048; m += NGW) row_to_bf16(mem + (size_t)m * DM, MEMB + (size_t)m * DM, lane);
        __syncthreads();
    }
    SEAM(0);
    if (IN(1)) {
        { pg8::Gemm g{UB, WSB, T_TOK, NP0, 1024}; pg8::StaticOrder S; S.init(T_TOK, NP0, G, bx); EpiBf16Plain E{PROJ, NP0}; pg8::gemm_phase(lds, g, S, E); }
        { pg8::Gemm g{MEMB, WKV, 2048, 1024, 1024}; pg8::StaticOrder S; S.init(2048, 1024, G, bx); EpiBf16Plain E{MEMKV, 1024}; pg8::gemm_phase(lds, g, S, E); }
    }
    SEAM(1);
    if (IN(2)) {
        naive_sb_attn(PROJ, MIX, gtid, nthr);
        naive_mem_attn(PROJ, NP0, 2304, MEMKV, MIX, gtid, nthr);
    }
    SEAM(2);
    if (IN(3)) { pg8::Gemm g{MIX, WOUT, T_TOK, 1024, 1024}; pg8::StaticOrder S; S.init(T_TOK, 1024, G, bx);
        EpiResid<0> E{x, out, UB, nullptr, STA, nullptr, nullptr}; pg8::gemm_phase(lds, g, S, E); }
    SEAM(3);
    if (IN(4)) { pg8::Gemm g{UB, WUP, T_TOK, 4096, 1024}; pg8::StaticOrder S; S.init(T_TOK, 4096, G, bx);
        EpiUp E{HB, STA, C1UP0, C2UP0}; pg8::gemm_phase(lds, g, S, E); }
    SEAM(4);
    if (IN(5)) { pg8::Gemm g{HB, WDN, T_TOK, 1024, 4096}; pg8::StaticOrder S; S.init(T_TOK, 1024, G, bx);
        EpiResid<1> E{out, out, UB, STA, STB, ln_mix_g, ln_mix_b}; pg8::gemm_phase(lds, g, S, E); }
    SEAM(5);
    if (IN(6)) { pg8::Gemm g{UB, WHG, T_TOK, NP1, 1024}; pg8::StaticOrder S; S.init(T_TOK, NP1, G, bx);
        EpiProj1 E{PROJ, LOGF, STB, C1HG, C2HG, lower_bounds}; pg8::gemm_phase(lds, g, S, E); }
    SEAM(6);
    if (IN(7)) {
        naive_mem_attn(PROJ, NP1, 3072, MEMKV + 512, MIX, gtid, nthr);
        __syncthreads();
        naive_hgrn(lds, PROJ, LOGF, hg_norm_g, MIX, G);
    }
    SEAM(7);
    if (IN(8)) { pg8::Gemm g{MIX, WOUT + 1024 * 1024, T_TOK, 1024, 1024}; pg8::StaticOrder S; S.init(T_TOK, 1024, G, bx);
        EpiResid<1> E{out, out, UB, STB, STA, ln_ffn_g, ln_ffn_b}; pg8::gemm_phase(lds, g, S, E); }
    SEAM(8);
    if (IN(9)) { pg8::Gemm g{UB, WUP + 4096 * 1024, T_TOK, 4096, 1024}; pg8::StaticOrder S; S.init(T_TOK, 4096, G, bx);
        EpiUp E{HB, STA, C1UP1, C2UP1}; pg8::gemm_phase(lds, g, S, E); }
    SEAM(9);
    if (IN(10)) { pg8::Gemm g{HB, WDN + 1024 * 4096, T_TOK, 1024, 4096}; pg8::StaticOrder S; S.init(T_TOK, 1024, G, bx);
        EpiResid<1> E{out, out, nullptr, STA, STB, ln_mix_g + 1024, ln_mix_b + 1024}; pg8::gemm_phase(lds, g, S, E); }
    SEAM(10);
    if (IN(11)) {
        const int gw = bx * 8 + wave, NGW = G * 8;
        const float* gg = ln_ffn_g + 1024; const float* bb = ln_ffn_b + 1024;
        for (int m = gw; m < T_TOK; m += NGW) {
            f32x4* xr = (f32x4*)(out + (size_t)m * DM) + lane;
            f32x4 v[4]; float s = 0.f;
#pragma unroll
            for (int j = 0; j < 4; ++j) { v[j] = xr[64 * j]; s += (v[j][0] + v[j][1]) + (v[j][2] + v[j][3]); }
            const float mean = wave_sum(s) * (1.f / DM); float s2 = 0.f;
#pragma unroll
            for (int j = 0; j < 4; ++j) { v[j] = v[j] - mean; s2 += (v[j][0] * v[j][0] + v[j][1] * v[j][1]) + (v[j][2] * v[j][2] + v[j][3] * v[j][3]); }
            const float rstd = 1.f / sqrtf(wave_sum(s2) * (1.f / DM) + LN_EPS);
#pragma unroll
            for (int j = 0; j < 4; ++j) { const f32x4 g4 = *((const f32x4*)gg + lane + 64 * j), b4 = *((const f32x4*)bb + lane + 64 * j); xr[64 * j] = v[j] * rstd * g4 + b4; }
        }
    }
#undef IN
#undef SEAM
}

constexpr int N_PHASES = 12;
extern "C" void kernel_launch(void* const* d_in, const int* in_sizes, int n_in, void* d_out, int out_size, void* d_ws, size_t ws_size, hipStream_t stream) {
    static int grid = 0;
    if (grid == 0) {
        if (n_in != 14 || in_sizes[0] != T_TOK * DM || out_size != T_TOK * DM || ws_size < WS_END) { fprintf(stderr, "kernel_launch: unexpected shapes (n_in %d, ws %zu)\n", n_in, ws_size); grid = -1; return; }
        int dev = 0, cus = 0, per_cu = 0;
        hipGetDevice(&dev); hipDeviceGetAttribute(&cus, hipDeviceAttributeMultiprocessorCount, dev);
        if (hipFuncSetAttribute((const void*)fwd_kernel, hipFuncAttributeMaxDynamicSharedMemorySize, LDS_BYTES) != hipSuccess) { fprintf(stderr, "kernel_launch: hipFuncSetAttribute failed\n"); grid = -1; return; }
        if (hipOccupancyMaxActiveBlocksPerMultiprocessor(&per_cu, (const void*)fwd_kernel, 512, LDS_BYTES) != hipSuccess || per_cu < 1) { fprintf(stderr, "kernel_launch: occupancy query says %d\n", per_cu); per_cu = 1; }
        (void)hipGetLastError();
        grid = cus * 1;
    }
    if (grid < 0) return;
    hipMemsetAsync((char*)d_ws + WS_CTL, 0, CTL_ZERO_BYTES, stream);
    Args a{};
    for (int i = 0; i < 14; ++i) a.in[i] = (const float*)d_in[i];
    a.out = (float*)d_out; a.ws = (unsigned char*)d_ws;
#if ONE_LAUNCH
    a.ph_lo = 0; a.ph_hi = N_PHASES;
    void* kargs[] = {&a};
    hipError_t e = hipLaunchCooperativeKernel((const void*)fwd_kernel, dim3(grid), dim3(512), kargs, LDS_BYTES, stream);
    if (e != hipSuccess) fprintf(stderr, "cooperative launch failed: %s (grid %d)\n", hipGetErrorString(e), grid);
#else
    for (int p = 0; p < N_PHASES; ++p) { a.ph_lo = p; a.ph_hi = p + 1; hipLaunchKernelGGL(fwd_kernel, dim3(grid), dim3(512), LDS_BYTES, stream, a); }
#endif
}
```

```cpp
#include <hip/hip_runtime.h>
#include <hip/hip_cooperative_groups.h>
#include <cstdio>
namespace cg = cooperative_groups;

#define LAS __attribute__((address_space(3)))
typedef unsigned short bf16_t;
typedef short bf16x8 __attribute__((ext_vector_type(8)));
typedef float f32x4 __attribute__((ext_vector_type(4)));
typedef float f32x2 __attribute__((ext_vector_type(2)));
typedef unsigned u32x4 __attribute__((ext_vector_type(4)));
typedef unsigned u32x2 __attribute__((ext_vector_type(2)));

constexpr int T_TOK = 32768, SEQ = 4096, DM = 1024, DFF = 4096;
constexpr int NP0 = 2560, NP1 = 3328;
constexpr float ALPHA = 1.41421356237f, LN_EPS = 1e-5f, RMS_EPS = 1e-6f;

constexpr size_t MiB = 1u << 20;
constexpr size_t WS_CTL = 0, CTL_ZERO_BYTES = 1024 * 1024;
constexpr size_t OFF_ST1 = 131072, OFF_ST2 = 131072 + 262144, OFF_ST3 = 131072 + 2 * 262144;
constexpr size_t OFF_C1HG = 0, OFF_C2HG = 16384, OFF_C1UP0 = 32768, OFF_C2UP0 = 49152, OFF_C1UP1 = 65536, OFF_C2UP1 = 81920;
constexpr size_t WS_WSB = 1 * MiB, WS_WHG = 6 * MiB, WS_WKV = 13 * MiB, WS_WOUT = 15 * MiB, WS_WUP = 19 * MiB, WS_WDN = 35 * MiB;
constexpr size_t WS_MEMB = 51 * MiB, WS_MEMKV = 55 * MiB;
constexpr size_t WS_UB = 68 * MiB, WS_MIX = 132 * MiB, WS_PROJ = 196 * MiB, WS_LOGF = 404 * MiB, WS_H = 196 * MiB, WS_END = 500 * MiB;
static_assert(WS_PROJ + (size_t)T_TOK * NP1 * 2 <= WS_LOGF, "proj");
static_assert(WS_LOGF + (size_t)T_TOK * 768 * 4 <= WS_END, "logf");
static_assert(WS_H + (size_t)T_TOK * DFF * 2 <= WS_END, "h");

constexpr int LDS_BYTES = 147456;

__device__ __forceinline__ unsigned cvt_pk_bf16(float lo, float hi) { unsigned r; asm volatile("v_cvt_pk_bf16_f32 %0, %1, %2" : "=v"(r) : "v"(lo), "v"(hi)); return r; }
__device__ __forceinline__ float bf2f(bf16_t b) { return __uint_as_float(((unsigned)b) << 16); }
__device__ __forceinline__ float bflo(unsigned w) { return __uint_as_float(w << 16); }
__device__ __forceinline__ float bfhi(unsigned w) { return __uint_as_float(w & 0xffff0000u); }
__device__ __forceinline__ bf16_t f2bf(float f) { return (bf16_t)(cvt_pk_bf16(f, 0.f) & 0xffffu); }
__device__ __forceinline__ float wave_sum(float v) {
#pragma unroll
    for (int o = 1; o < 64; o <<= 1) v += __shfl_xor(v, o);
    return v;
}

namespace pg8 {
constexpr int BM = 256, BK = 64, HALF = 128, HTB = HALF * BK * 2, STAGE_BYTES = 8 * HTB, NXCD = 8, WGM = 4;
__host__ __device__ __forceinline__ int lds_byte(int r, int c) { const int st = (r >> 4) * 2 + (c >> 5), rr = r & 15, cc = c & 31, ob = rr * 64 + cc * 2; return st * 1024 + (ob ^ (((ob >> 9) & 1) << 5)); }
__host__ __device__ __forceinline__ void stage_rc(int b, int& R, int& C) { const int st = b / 1024, sb = b % 1024, swz = sb ^ (((sb >> 9) & 1) << 5); R = (st >> 1) * 16 + swz / 64; C = (st & 1) * 32 + (swz % 64) / 2; }
__host__ __device__ __forceinline__ int perm32(int rho) { const int n = rho >> 4, i = rho & 15; return 8 * (i >> 2) + 4 * n + (i & 3); }
struct Unit { int pm, pn; };
struct Gemm { const bf16_t* A; const bf16_t* Bt; int M, N, K; };
struct StaticOrder {
    int nM, nN, nwg, G, c;
    __host__ __device__ void init(int M, int N, int G_, int c_) { nM = M / BM; nN = N / BM; nwg = nM * nN; G = G_; c = c_; }
    __host__ __device__ bool next(int i, Unit& u) const {
        const long L = (long)i * G + c; if (L >= nwg) return false;
        int wgid = (int)L; { const int q = nwg / NXCD, r = nwg % NXCD, xcd = wgid % NXCD, off = wgid / NXCD; wgid = (xcd < r ? xcd * (q + 1) : r * (q + 1) + (xcd - r) * q) + off; }
        const int nig = WGM * nN, gid = wgid / nig, fm = gid * WGM, gsz = (nM - fm) < WGM ? (nM - fm) : WGM;
        u.pm = fm + ((wgid % nig) % gsz); u.pn = (wgid % nig) / gsz; return true;
    }
};

template <class Epi, class Sched, bool ALIGN_EPI = true, bool SP2 = true>
__device__ __forceinline__ void gemm_phase(LAS unsigned char* lds, const Gemm g, const Sched& S, const Epi& E) {
    const int tid = threadIdx.x, wid = __builtin_amdgcn_readfirstlane(tid >> 6), lane = tid & 63, wr = wid >> 2, wc = wid & 3, fr = lane & 15, fq = lane >> 4;
    const int K = g.K, nt = K / BK;
    unsigned voffA[2], voffB[2];
#pragma unroll
    for (int i = 0; i < 2; ++i) { int R, C; stage_rc(tid * 16 + i * 8192, R, C); const int Rb = Epi::PERM ? ((R & ~31) + perm32(R & 31)) : R;
        voffA[i] = (unsigned)(R * K + C) * 2u; voffB[i] = (unsigned)(Rb * K + C) * 2u; }
    const size_t kstep = (size_t)(BK * 2);
    const size_t hstep = (size_t)HALF * K * 2;
    const size_t tstep = 2 * hstep;
    const unsigned ldsw = (unsigned)wid * 1024u;
    const int aoff = lds_byte(wr * 64 + fr, fq * 8), boff = lds_byte(wc * 32 + fr, fq * 8);
#define PG8_SA(b, h) (((b) * 2 + (h)) * HTB)
#define PG8_SB(b, h) ((4 + (b) * 2 + (h)) * HTB)
#define PG8_STAGE(bufoff, gbase, voff) do { _Pragma("unroll") for (int _i = 0; _i < 2; ++_i) \
        __builtin_amdgcn_global_load_lds((const unsigned*)((const char*)(gbase) + (voff)[_i]), (LAS unsigned*)(lds + (bufoff) + ldsw + _i * 8192), 16, 0, 0); } while (0)
#define PG8_LDA(dst, b, h) do { _Pragma("unroll") for (int m = 0; m < 4; ++m) _Pragma("unroll") for (int k = 0; k < 2; ++k) dst[m][k] = *(const LAS bf16x8*)(lds + PG8_SA(b, h) + aoff + m * 2048 + k * 1024); } while (0)
#define PG8_LDB(dst, b, h) do { _Pragma("unroll") for (int n = 0; n < 2; ++n) _Pragma("unroll") for (int k = 0; k < 2; ++k) dst[n][k] = *(const LAS bf16x8*)(lds + PG8_SB(b, h) + boff + n * 2048 + k * 1024); } while (0)
#define PG8_MMA(ai, bj, At, Bt) do { __builtin_amdgcn_s_setprio(1); _Pragma("unroll") for (int m = 0; m < 4; ++m) _Pragma("unroll") for (int n = 0; n < 2; ++n) _Pragma("unroll") for (int k = 0; k < 2; ++k) \
        acc[ai][bj][m][n] = __builtin_amdgcn_mfma_f32_16x16x32_bf16(Bt[n][k], At[m][k], acc[ai][bj][m][n], 0, 0, 0); __builtin_amdgcn_s_setprio(0); } while (0)
#define PG8_WAIT_V(n) asm volatile("s_waitcnt vmcnt(" #n ")" ::: "memory")
#define PG8_WAIT_L(n) asm volatile("s_waitcnt lgkmcnt(" #n ")" ::: "memory")
#define PG8_BAR __builtin_amdgcn_s_barrier()
#define PG8_SCHED __builtin_amdgcn_sched_barrier(0)
    Unit cur, nxt; int ui = 0;
    if (!S.next(0, cur)) return;
    f32x4 acc[2][2][4][2];
#pragma unroll
    for (int a = 0; a < 2; ++a)
#pragma unroll
        for (int b = 0; b < 2; ++b)
#pragma unroll
            for (int m = 0; m < 4; ++m)
#pragma unroll
                for (int n = 0; n < 2; ++n) acc[a][b][m][n] = (f32x4){0.f, 0.f, 0.f, 0.f};
    bf16x8 At[4][2], B0[2][2], B1[2][2];
    const char* cA = (const char*)g.A + (size_t)cur.pm * tstep; const char* cB = (const char*)g.Bt + (size_t)cur.pn * tstep;
    if constexpr (SP2) {
        PG8_STAGE(PG8_SB(0, 0), cB, voffB); PG8_STAGE(PG8_SB(0, 1), cB + hstep, voffB); PG8_STAGE(PG8_SA(0, 0), cA, voffA); PG8_STAGE(PG8_SA(0, 1), cA + hstep, voffA);
        if (wr == 1) PG8_BAR;
        PG8_WAIT_V(2); PG8_BAR;
        PG8_STAGE(PG8_SB(1, 0), cB + kstep, voffB); PG8_STAGE(PG8_SA(1, 0), cA + kstep, voffA); PG8_STAGE(PG8_SB(1, 1), cB + hstep + kstep, voffB);
        PG8_WAIT_V(6); PG8_BAR;
    } else {
        PG8_STAGE(PG8_SB(0, 0), cB, voffB); PG8_STAGE(PG8_SA(0, 0), cA, voffA); PG8_STAGE(PG8_SB(0, 1), cB + hstep, voffB); PG8_STAGE(PG8_SA(0, 1), cA + hstep, voffA);
        if (wr == 1) PG8_BAR;
        PG8_WAIT_V(4); PG8_BAR;
        PG8_STAGE(PG8_SB(1, 0), cB + kstep, voffB); PG8_STAGE(PG8_SA(1, 0), cA + kstep, voffA); PG8_STAGE(PG8_SB(1, 1), cB + hstep + kstep, voffB);
        PG8_WAIT_V(6); PG8_BAR;
    }
    for (;;) {
        const bool has_next = S.next(ui + 1, nxt);
        const char* nA = has_next ? (const char*)g.A + (size_t)nxt.pm * tstep : cA; const char* nB = has_next ? (const char*)g.Bt + (size_t)nxt.pn * tstep : cB;
        for (int t = 0; t < nt; t += 2) {
            const bool last = (t == nt - 2);
            const char* a1 = cA + (size_t)(t + 1) * kstep;
            const char* a2 = last ? nA : cA + (size_t)(t + 2) * kstep; const char* b2 = last ? nB : cB + (size_t)(t + 2) * kstep;
            const char* a3 = a2 + kstep; const char* b3 = b2 + kstep;
            if constexpr (SP2) {
            PG8_LDB(B0, 0, 0); PG8_LDB(B1, 0, 1); PG8_SCHED; PG8_LDA(At, 0, 0); PG8_STAGE(PG8_SA(1, 1), a1 + hstep, voffA);
            PG8_WAIT_V(8); PG8_WAIT_L(0); PG8_BAR; PG8_MMA(0, 0, At, B0); PG8_MMA(0, 1, At, B1); PG8_BAR; PG8_SCHED;
            PG8_LDA(At, 0, 1); PG8_STAGE(PG8_SB(0, 0), b2, voffB); PG8_STAGE(PG8_SB(0, 1), b2 + hstep, voffB); PG8_STAGE(PG8_SA(0, 0), a2, voffA);
            PG8_WAIT_V(8); PG8_WAIT_L(0); PG8_BAR; PG8_MMA(1, 0, At, B0); PG8_MMA(1, 1, At, B1); PG8_BAR; PG8_SCHED;
            PG8_LDB(B0, 1, 0); PG8_LDB(B1, 1, 1); PG8_SCHED; PG8_LDA(At, 1, 0); PG8_STAGE(PG8_SA(0, 1), a2 + hstep, voffA);
            PG8_WAIT_V(8); PG8_WAIT_L(0); PG8_BAR; PG8_MMA(0, 0, At, B0); PG8_MMA(0, 1, At, B1); PG8_BAR; PG8_SCHED;
            PG8_LDA(At, 1, 1); PG8_STAGE(PG8_SB(1, 0), b3, voffB); PG8_STAGE(PG8_SB(1, 1), b3 + hstep, voffB); PG8_STAGE(PG8_SA(1, 0), a3, voffA);
            PG8_WAIT_V(8); PG8_WAIT_L(0); PG8_BAR; PG8_MMA(1, 0, At, B0); PG8_MMA(1, 1, At, B1); PG8_BAR; PG8_SCHED;
            } else {
            PG8_LDB(B0, 0, 0); PG8_SCHED; PG8_LDA(At, 0, 0); PG8_STAGE(PG8_SA(1, 1), a1 + hstep, voffA);
            PG8_WAIT_L(8); PG8_BAR; PG8_WAIT_L(0); PG8_MMA(0, 0, At, B0); PG8_BAR; PG8_SCHED;
            PG8_LDB(B1, 0, 1); PG8_STAGE(PG8_SB(0, 0), b2, voffB);
            PG8_BAR; PG8_WAIT_L(0); PG8_MMA(0, 1, At, B1); PG8_BAR;
            PG8_LDA(At, 0, 1); PG8_STAGE(PG8_SA(0, 0), a2, voffA);
            PG8_BAR; PG8_WAIT_L(0); PG8_MMA(1, 0, At, B0); PG8_BAR; PG8_SCHED;
            PG8_STAGE(PG8_SB(0, 1), b2 + hstep, voffB);
            PG8_WAIT_V(6); PG8_BAR; PG8_MMA(1, 1, At, B1); PG8_BAR;
            PG8_LDB(B0, 1, 0); PG8_SCHED; PG8_LDA(At, 1, 0); PG8_STAGE(PG8_SA(0, 1), a2 + hstep, voffA);
            PG8_WAIT_L(8); PG8_BAR; PG8_WAIT_L(0); PG8_MMA(0, 0, At, B0); PG8_BAR; PG8_SCHED;
            PG8_LDB(B1, 1, 1); PG8_STAGE(PG8_SB(1, 0), b3, voffB);
            PG8_BAR; PG8_WAIT_L(0); PG8_MMA(0, 1, At, B1); PG8_BAR;
            PG8_LDA(At, 1, 1); PG8_STAGE(PG8_SA(1, 0), a3, voffA);
            PG8_BAR; PG8_WAIT_L(0); PG8_MMA(1, 0, At, B0); PG8_BAR; PG8_SCHED;
            PG8_STAGE(PG8_SB(1, 1), b3 + hstep, voffB);
            PG8_WAIT_V(6); PG8_BAR; PG8_MMA(1, 1, At, B1); PG8_BAR;
            }
        }
        if constexpr (ALIGN_EPI) { if (wr == 0) PG8_BAR; }
        E(acc, cur, wr, wc, fr, fq);
        if (!has_next) break;
#pragma unroll
        for (int a = 0; a < 2; ++a)
#pragma unroll
            for (int b = 0; b < 2; ++b)
#pragma unroll
                for (int m = 0; m < 4; ++m)
#pragma unroll
                    for (int n = 0; n < 2; ++n) acc[a][b][m][n] = (f32x4){0.f, 0.f, 0.f, 0.f};
        cur = nxt; cA = nA; cB = nB; ++ui;
        if constexpr (ALIGN_EPI) { if (wr == 1) PG8_BAR; }
    }
    PG8_WAIT_V(0);
    if constexpr (!ALIGN_EPI) { if (wr == 0) PG8_BAR; }
    PG8_BAR;
#undef PG8_SA
#undef PG8_SB
#undef PG8_STAGE
#undef PG8_LDA
#undef PG8_LDB
#undef PG8_MMA
#undef PG8_WAIT_V
#undef PG8_WAIT_L
#undef PG8_BAR
#undef PG8_SCHED
}
}

typedef f32x4 AccT[2][2][4][2];

__device__ __forceinline__ void mean_rstd(const f32x2 sv, float& mean, float& rstd) {
    mean = sv[0] * (1.f / DM);
    rstd = 1.0f / sqrtf(fmaxf(sv[1] * (1.f / DM) - mean * mean, 0.f) + LN_EPS);
}
__device__ __forceinline__ void stat_add(float* st, int row, float s1, float s2) {
    (void)__hip_atomic_fetch_add(st + 2 * (size_t)row, s1, __ATOMIC_RELAXED, __HIP_MEMORY_SCOPE_AGENT);
    (void)__hip_atomic_fetch_add(st + 2 * (size_t)row + 1, s2, __ATOMIC_RELAXED, __HIP_MEMORY_SCOPE_AGENT);
}

#define AT(T, base, byteoff) (*(T*)((char*)(base) + (size_t)(unsigned)(byteoff)))
#define ATC(T, base, byteoff) (*(const T*)((const char*)(base) + (size_t)(unsigned)(byteoff)))

struct EpiBf16Plain {
    static constexpr bool PERM = true;
    bf16_t* O; int ldc;
    __device__ __forceinline__ void operator()(const AccT& acc, const pg8::Unit& u, int wr, int wc, int fr, int fq) const {
        const int row0 = u.pm * 256 + wr * 64 + fr, col0 = u.pn * 256 + wc * 32 + 8 * fq;
        const unsigned rstride = (unsigned)ldc * 2u;
#pragma unroll
        for (int ai = 0; ai < 2; ++ai)
#pragma unroll
            for (int m = 0; m < 4; ++m) { const unsigned off = (unsigned)(row0 + ai * 128 + m * 16) * rstride + (unsigned)col0 * 2u;
#pragma unroll
                for (int bj = 0; bj < 2; ++bj) { const f32x4 v0 = acc[ai][bj][m][0], v1 = acc[ai][bj][m][1];
                    u32x4 w; w.x = cvt_pk_bf16(v0[0], v0[1]); w.y = cvt_pk_bf16(v0[2], v0[3]); w.z = cvt_pk_bf16(v1[0], v1[1]); w.w = cvt_pk_bf16(v1[2], v1[3]);
                    AT(u32x4, O, off + bj * 256) = w; } }
    }
};

template <int MODE, int WSTATS> struct EpiResid {
    static constexpr bool PERM = true;
    const float* xin; bf16_t* ub; const float* stats_in; float* stats_out; const float* g; const float* b;
    __device__ __forceinline__ void operator()(const AccT& acc, const pg8::Unit& u, int wr, int wc, int fr, int fq) const {
        const int row0 = u.pm * 256 + wr * 64 + fr, col0 = u.pn * 256 + wc * 32 + 8 * fq;
        f32x4 gv[2][2], bv[2][2]; f32x2 sv[8];
        if (MODE == 1) {
#pragma unroll
            for (int k = 0; k < 8; ++k) sv[k] = ATC(f32x2, stats_in, (unsigned)(row0 + (k >> 2) * 128 + (k & 3) * 16) * 8u);
#pragma unroll
            for (int bj = 0; bj < 2; ++bj)
#pragma unroll
                for (int n = 0; n < 2; ++n) { gv[bj][n] = ATC(f32x4, g, (unsigned)(col0 + bj * 128 + 4 * n) * 4u); bv[bj][n] = ATC(f32x4, b, (unsigned)(col0 + bj * 128 + 4 * n) * 4u); }
        }
        u32x4 rwn[2][2];
        if (MODE == 1) {
#pragma unroll
            for (int mm = 0; mm < 2; ++mm)
#pragma unroll
                for (int bj = 0; bj < 2; ++bj) rwn[mm][bj] = ATC(u32x4, ub, ((unsigned)(row0 + mm * 16) * (unsigned)DM + (unsigned)(col0 + bj * 128)) * 2u);
        }
#pragma unroll
        for (int bt = 0; bt < 4; ++bt) {
            const int ai = bt >> 1, mp = bt & 1;
            f32x4 rx[2][2][2]; u32x4 rw[2][2];
            if (MODE == 1) {
#pragma unroll
                for (int mm = 0; mm < 2; ++mm)
#pragma unroll
                    for (int bj = 0; bj < 2; ++bj) rw[mm][bj] = rwn[mm][bj];
                if (bt < 3) {
                    const int ai2 = (bt + 1) >> 1, mp2 = (bt + 1) & 1;
#pragma unroll
                    for (int mm = 0; mm < 2; ++mm)
#pragma unroll
                        for (int bj = 0; bj < 2; ++bj) rwn[mm][bj] = ATC(u32x4, ub, ((unsigned)(row0 + ai2 * 128 + (2 * mp2 + mm) * 16) * (unsigned)DM + (unsigned)(col0 + bj * 128)) * 2u);
                }
            } else {
#pragma unroll
                for (int mm = 0; mm < 2; ++mm)
#pragma unroll
                    for (int bj = 0; bj < 2; ++bj) {
                        const unsigned eoff = (unsigned)(row0 + ai * 128 + (2 * mp + mm) * 16) * (unsigned)DM + (unsigned)(col0 + bj * 128);
                        rx[mm][bj][0] = ATC(f32x4, xin, eoff * 4u); rx[mm][bj][1] = ATC(f32x4, xin, eoff * 4u + 16u);
                    }
            }
#pragma unroll
            for (int mm = 0; mm < 2; ++mm) {
                const int m = 2 * mp + mm, row = row0 + ai * 128 + m * 16;
                float mu = 0.f, rs = 1.f;
                if (MODE == 1) mean_rstd(sv[ai * 4 + m], mu, rs);
                float s1 = 0.f, s2 = 0.f;
#pragma unroll
                for (int bj = 0; bj < 2; ++bj) {
                    f32x4 r0, r1;
                    if (MODE == 1) { const u32x4 wv = rw[mm][bj];
                        r0 = (f32x4){bflo(wv.x), bfhi(wv.x), bflo(wv.y), bfhi(wv.y)}; r1 = (f32x4){bflo(wv.z), bfhi(wv.z), bflo(wv.w), bfhi(wv.w)};
                        r0 = (r0 - mu) * rs * gv[bj][0] + bv[bj][0]; r1 = (r1 - mu) * rs * gv[bj][1] + bv[bj][1]; }
                    else { r0 = rx[mm][bj][0]; r1 = rx[mm][bj][1]; }
                    const f32x4 o0 = r0 * ALPHA + acc[ai][bj][m][0], o1 = r1 * ALPHA + acc[ai][bj][m][1];
                    u32x4 w; w.x = cvt_pk_bf16(o0[0], o0[1]); w.y = cvt_pk_bf16(o0[2], o0[3]); w.z = cvt_pk_bf16(o1[0], o1[1]); w.w = cvt_pk_bf16(o1[2], o1[3]);
                    AT(u32x4, ub, ((unsigned)row * (unsigned)DM + (unsigned)(col0 + bj * 128)) * 2u) = w;
                    if (WSTATS) {
                        s1 += ((o0[0] + o0[1]) + (o0[2] + o0[3])) + ((o1[0] + o1[1]) + (o1[2] + o1[3]));
                        s2 += ((o0[0] * o0[0] + o0[1] * o0[1]) + (o0[2] * o0[2] + o0[3] * o0[3])) + ((o1[0] * o1[0] + o1[1] * o1[1]) + (o1[2] * o1[2] + o1[3] * o1[3])); }
                }
                if (WSTATS) {
                    s1 += __shfl_xor(s1, 16); s2 += __shfl_xor(s2, 16); s1 += __shfl_xor(s1, 32); s2 += __shfl_xor(s2, 32);
                    if (fq == 0) stat_add(stats_out, row, s1, s2); }
            }
        }
    }
};

struct EpiUp {
    static constexpr bool PERM = true;
    bf16_t* O; const float* stats_in; const float* c1; const float* c2;
    __device__ __forceinline__ void operator()(const AccT& acc, const pg8::Unit& u, int wr, int wc, int fr, int fq) const {
        const int row0 = u.pm * 256 + wr * 64 + fr, col0 = u.pn * 256 + wc * 32 + 8 * fq;
        f32x2 sv[8];
#pragma unroll
        for (int k = 0; k < 8; ++k) sv[k] = ATC(f32x2, stats_in, (unsigned)(row0 + (k >> 2) * 128 + (k & 3) * 16) * 8u);
#pragma unroll
        for (int bj = 0; bj < 2; ++bj) {
            const f32x4 c10 = ATC(f32x4, c1, (unsigned)(col0 + bj * 128) * 4u), c11 = ATC(f32x4, c1, (unsigned)(col0 + bj * 128 + 4) * 4u);
            const f32x4 c20 = ATC(f32x4, c2, (unsigned)(col0 + bj * 128) * 4u), c21 = ATC(f32x4, c2, (unsigned)(col0 + bj * 128 + 4) * 4u);
#pragma unroll
            for (int ai = 0; ai < 2; ++ai)
#pragma unroll
                for (int m = 0; m < 4; ++m) {
                    const int row = row0 + ai * 128 + m * 16;
                    float mean, rstd; mean_rstd(sv[ai * 4 + m], mean, rstd);
                    f32x4 v0 = (acc[ai][bj][m][0] - mean * c10) * rstd + c20;
                    f32x4 v1 = (acc[ai][bj][m][1] - mean * c11) * rstd + c21;
#pragma unroll
                    for (int j = 0; j < 4; ++j) { const float a = fmaxf(v0[j], 0.f), c = fmaxf(v1[j], 0.f); v0[j] = a * a; v1[j] = c * c; }
                    u32x4 w; w.x = cvt_pk_bf16(v0[0], v0[1]); w.y = cvt_pk_bf16(v0[2], v0[3]); w.z = cvt_pk_bf16(v1[0], v1[1]); w.w = cvt_pk_bf16(v1[2], v1[3]);
                    AT(u32x4, O, ((unsigned)row * (unsigned)DFF + (unsigned)(col0 + bj * 128)) * 2u) = w;
                }
        }
    }
};

struct EpiProj1 {
    static constexpr bool PERM = true;
    bf16_t* O; float* logf; const float* stats_in; const float* c1; const float* c2; const float* lbin;
    __device__ __forceinline__ void operator()(const AccT& acc, const pg8::Unit& u, int wr, int wc, int fr, int fq) const {
        const int row0 = u.pm * 256 + wr * 64 + fr, col0 = u.pn * 256 + wc * 32 + 8 * fq;
        const int kind = u.pn / 3;
        f32x2 sv[8];
#pragma unroll
        for (int k = 0; k < 8; ++k) sv[k] = ATC(f32x2, stats_in, (unsigned)(row0 + (k >> 2) * 128 + (k & 3) * 16) * 8u);
#pragma unroll
        for (int bj = 0; bj < 2; ++bj) {
            f32x4 c1v[2], c2v[2], lbv[2];
#pragma unroll
            for (int n = 0; n < 2; ++n) { c1v[n] = ATC(f32x4, c1, (unsigned)(col0 + bj * 128 + 4 * n) * 4u); c2v[n] = ATC(f32x4, c2, (unsigned)(col0 + bj * 128 + 4 * n) * 4u); lbv[n] = (f32x4){0.f, 0.f, 0.f, 0.f}; }
            if (kind == 1) {
#pragma unroll
                for (int n = 0; n < 2; ++n) {
                    const unsigned j0 = (unsigned)(col0 - 768 + bj * 128 + 4 * n);
                    const f32x4 l0 = ATC(f32x4, lbin, j0 * 4u), l1 = ATC(f32x4, lbin, (768u + j0) * 4u);
#pragma unroll
                    for (int j = 0; j < 4; ++j) { const float mx = fmaxf(l0[j], l1[j]), e0 = __expf(l0[j] - mx), e1 = __expf(l1[j] - mx), sm = e0 + e1, p0 = e0 / sm, p1 = e1 / sm; lbv[n][j] = (p0 + p1) - p0; }
                }
            }
#pragma unroll
            for (int ai = 0; ai < 2; ++ai)
#pragma unroll
                for (int m = 0; m < 4; ++m) {
                    const int row = row0 + ai * 128 + m * 16;
                    float mean, rstd; mean_rstd(sv[ai * 4 + m], mean, rstd);
                    f32x4 v[2];
                    v[0] = (acc[ai][bj][m][0] - mean * c1v[0]) * rstd + c2v[0];
                    v[1] = (acc[ai][bj][m][1] - mean * c1v[1]) * rstd + c2v[1];
                    if (kind == 1) {
                        const unsigned cf = (unsigned)(col0 - 768 + bj * 128);
                        const unsigned loff = ((cf >> 7) * (unsigned)(T_TOK * 128) + (unsigned)row * 128u + (cf & 127u)) * 4u;
#pragma unroll
                        for (int n = 0; n < 2; ++n) { f32x4 lf;
#pragma unroll
                            for (int j = 0; j < 4; ++j) { const float z = fminf(fmaxf(v[n][j], -80.f), 80.f), t = __expf(-z), sg = 1.0f / (1.0f + t), lb = lbv[n][j];
                                lf[j] = __logf(lb + (1.0f - lb) * sg); v[n][j] = (1.0f - lb) * (t * sg); }
                            AT(f32x4, logf, loff + 16u * n) = lf; }
                    } else if (kind == 3) {
#pragma unroll
                        for (int n = 0; n < 2; ++n)
#pragma unroll
                            for (int j = 0; j < 4; ++j) { const float z = fminf(fmaxf(v[n][j], -80.f), 80.f); v[n][j] = v[n][j] / (1.0f + __expf(-z)); }
                    }
                    u32x4 w; w.x = cvt_pk_bf16(v[0][0], v[0][1]); w.y = cvt_pk_bf16(v[0][2], v[0][3]); w.z = cvt_pk_bf16(v[1][0], v[1][1]); w.w = cvt_pk_bf16(v[1][2], v[1][3]);
                    const unsigned cik = (unsigned)(col0 + bj * 128 - kind * 768);
                    const unsigned eoff = (kind < 4) ? (unsigned)kind * (unsigned)(6 * T_TOK * 128) + (cik >> 7) * (unsigned)(T_TOK * 128) + (unsigned)row * 128u + (cik & 127u)
                                                     : 4u * (unsigned)(6 * T_TOK * 128) + (unsigned)row * 256u + cik;
                    AT(u32x4, O, eoff * 2u) = w;
                }
        }
    }
};

#define LDS_WAIT() asm volatile("s_waitcnt lgkmcnt(0)" ::: "memory")
#define LDS_BARRIER() asm volatile("s_waitcnt lgkmcnt(0)\n\ts_barrier" ::: "memory")
__device__ __forceinline__ void p0_transpose_item(const float* W, int K, int N, bf16_t* WT, LAS float* scr, int item, int lane,
                                                  const float* g, const float* b, float* c1, float* c2) {
    const int nblk = N / 32, kb = item / nblk, nb = item % nblk, k0 = 64 * kb, n0 = 32 * nb;
    { f32x4 t[8];
#pragma unroll
      for (int i = 0; i < 8; ++i) t[i] = *(const f32x4*)(W + (size_t)(k0 + 8 * i + (lane >> 3)) * N + n0 + 4 * (lane & 7));
#pragma unroll
      for (int i = 0; i < 8; ++i) { LAS float* d = scr + (8 * i + (lane >> 3)) * 33 + 4 * (lane & 7); d[0] = t[i][0]; d[1] = t[i][1]; d[2] = t[i][2]; d[3] = t[i][3]; } }
    LDS_WAIT(); asm volatile("" ::: "memory");
    const int c = lane & 7;
    float gk[8], bk[8];
#pragma unroll
    for (int e = 0; e < 8; ++e) { gk[e] = g ? g[k0 + 8 * c + e] : 1.f; bk[e] = g ? b[k0 + 8 * c + e] : 0.f; }
#pragma unroll
    for (int j = 0; j < 4; ++j) { const int n = (lane >> 3) + 8 * j; const LAS float* s = scr + (8 * c) * 33 + n;
        float w[8], p2 = 0.f;
#pragma unroll
        for (int e = 0; e < 8; ++e) { const float x = s[e * 33]; w[e] = x * gk[e]; p2 += bk[e] * x; }
        u32x4 o; o.x = cvt_pk_bf16(w[0], w[1]); o.y = cvt_pk_bf16(w[2], w[3]); o.z = cvt_pk_bf16(w[4], w[5]); o.w = cvt_pk_bf16(w[6], w[7]);
        *(u32x4*)(WT + (size_t)(n0 + n) * K + k0 + 8 * c) = o;
        if (g) {
            float p1 = ((bflo(o.x) + bfhi(o.x)) + (bflo(o.y) + bfhi(o.y))) + ((bflo(o.z) + bfhi(o.z)) + (bflo(o.w) + bfhi(o.w)));
            p1 += __shfl_xor(p1, 1); p2 += __shfl_xor(p2, 1); p1 += __shfl_xor(p1, 2); p2 += __shfl_xor(p2, 2); p1 += __shfl_xor(p1, 4); p2 += __shfl_xor(p2, 4);
            if (c == 0) { atomicAdd(c1 + n0 + n, p1); atomicAdd(c2 + n0 + n, p2); }
        }
    }
    LDS_WAIT(); asm volatile("" ::: "memory");
}
__device__ __forceinline__ void row_to_bf16(const float* xrow, bf16_t* orow, int lane) {
    const f32x4* xr = (const f32x4*)xrow + lane; u32x2* o8 = (u32x2*)orow + lane;
#pragma unroll
    for (int j = 0; j < 4; ++j) { const f32x4 v = xr[64 * j]; u32x2 w; w.x = cvt_pk_bf16(v[0], v[1]); w.y = cvt_pk_bf16(v[2], v[3]); o8[64 * j] = w; }
}

struct Args { const float* in[14]; float* out; unsigned char* ws; int ph_lo, ph_hi; };

typedef float f32x16 __attribute__((ext_vector_type(16)));
#define MFMA32(a, b, c) __builtin_amdgcn_mfma_f32_32x32x16_bf16((a), (b), (c), 0, 0, 0)
constexpr int KV_PITCH = 144;
template <int O0, int O1, int O2, int O3>
__device__ __forceinline__ void tr_read4(unsigned addr, u32x2& r0, u32x2& r1, u32x2& r2, u32x2& r3) {
    asm volatile("ds_read_b64_tr_b16 %0, %4 offset:%5\n\tds_read_b64_tr_b16 %1, %4 offset:%6\n\tds_read_b64_tr_b16 %2, %4 offset:%7\n\tds_read_b64_tr_b16 %3, %4 offset:%8\n\ts_waitcnt lgkmcnt(0)"
                 : "=&v"(r0), "=&v"(r1), "=&v"(r2), "=&v"(r3) : "v"(addr), "n"(O0), "n"(O1), "n"(O2), "n"(O3) : "memory");
}
__device__ __forceinline__ bf16x8 pack8(float x0, float x1, float x2, float x3, float x4, float x5, float x6, float x7) {
    u32x4 p;
    asm volatile("v_cvt_pk_bf16_f32 %0, %4, %5\n\tv_cvt_pk_bf16_f32 %1, %6, %7\n\tv_cvt_pk_bf16_f32 %2, %8, %9\n\tv_cvt_pk_bf16_f32 %3, %10, %11\n\ts_nop 1"
                 : "=&v"(p[0]), "=&v"(p[1]), "=&v"(p[2]), "=&v"(p[3]) : "v"(x0), "v"(x1), "v"(x2), "v"(x3), "v"(x4), "v"(x5), "v"(x6), "v"(x7));
    return __builtin_bit_cast(bf16x8, p);
}
__device__ __forceinline__ bf16x8 as_bf16x8(u32x2 lo, u32x2 hi) { u32x4 p; p.x = lo.x; p.y = lo.y; p.z = hi.x; p.w = hi.y; return __builtin_bit_cast(bf16x8, p); }
__device__ __forceinline__ void pv_block(f32x16& o0, f32x16& o1, unsigned vaddr, bf16x8 pf0, bf16x8 pf1) {
    u32x2 a, b, c, d;
    tr_read4<0, 8 * KV_PITCH, 64, 8 * KV_PITCH + 64>(vaddr, a, b, c, d);
    o0 = MFMA32(as_bf16x8(a, b), pf0, o0); o1 = MFMA32(as_bf16x8(c, d), pf0, o1);
    tr_read4<16 * KV_PITCH, 24 * KV_PITCH, 16 * KV_PITCH + 64, 24 * KV_PITCH + 64>(vaddr, a, b, c, d);
    o0 = MFMA32(as_bf16x8(a, b), pf1, o0); o1 = MFMA32(as_bf16x8(c, d), pf1, o1);
}
__device__ __forceinline__ int crow(int i, int hh) { return (i & 3) + 8 * (i >> 2) + 4 * hh; }

struct SbState { f32x16 o0, o1; float C; bool wdone; int it, kt; };
__device__ __forceinline__ bool sb2_iter(LAS unsigned char* lds, SbState& st, u32x4 (&kreg)[2], u32x4 (&vreg)[2], const bf16_t* const (&gk)[2], const unsigned (&st_off)[2],
                                         const bf16x8 (&qf)[4], int w, int lane, int tq0) {
    constexpr int HB_ = 2 * 64 * KV_PITCH, BUF_ = 2 * HB_;
    const int r = lane & 31, hh = lane >> 5, hs = w >> 2, tq = tq0 + r, it = st.it, kt = st.kt;
    LAS unsigned* flags = (LAS unsigned*)(lds + 2 * BUF_);
    LAS unsigned char* buf = lds + (it & 1) * BUF_;
#pragma unroll
    for (int i = 0; i < 2; ++i) { *(LAS u32x4*)(buf + st_off[i]) = kreg[i]; *(LAS u32x4*)(buf + st_off[i] + 64 * KV_PITCH) = vreg[i]; }
    LDS_BARRIER();
    if (it > 0) { bool all = true;
#pragma unroll
        for (int i = 0; i < 8; ++i) all = all && (flags[((it - 1) & 1) * 8 + i] != 0u);
        if (all) return true; }
    if (kt >= 2) {
#pragma unroll
        for (int i = 0; i < 2; ++i) { kreg[i] = *(const u32x4*)(gk[i] + (size_t)(64 * (kt - 2)) * NP0); vreg[i] = *(const u32x4*)(gk[i] + (size_t)(64 * (kt - 2)) * NP0 + 768); } }
    const int k0 = 64 * kt;
    LAS unsigned char* kbuf = buf + hs * HB_; LAS unsigned char* vbuf = kbuf + 64 * KV_PITCH;
    const int i16 = lane & 15, q4 = i16 >> 2, p4 = i16 & 3, blk = (lane >> 4) & 1;
    const unsigned tr_lane = (4 * hh + q4) * KV_PITCH + 32 * blk + 8 * p4;
    float C = st.C;
    if (k0 <= tq0 && !st.wdone) {
        const bool need_mask = (k0 + 64 > tq0);
#pragma unroll
        for (int kbi = 0; kbi < 2; ++kbi) { const int kb = 1 - kbi;
            f32x16 sT;
#pragma unroll
            for (int i = 0; i < 16; ++i) sT[i] = 0.f;
            const LAS unsigned char* ka = kbuf + (32 * kb + r) * KV_PITCH + 16 * hh;
            { bf16x8 af[4];
#pragma unroll
              for (int s = 0; s < 4; ++s) af[s] = *(const LAS bf16x8*)(ka + 32 * s);
              asm volatile("" ::: "memory");
#pragma unroll
              for (int s = 0; s < 4; ++s) sT = MFMA32(af[s], qf[s], sT); }
            float a[16], be[16];
#pragma unroll
            for (int i = 0; i < 16; ++i) {
                const float z2 = fminf(sT[i] * (0.125f * 1.44269504f), 115.f);
                const float e = __builtin_amdgcn_exp2f(z2), av = __builtin_amdgcn_rcpf(1.0f + e);
                a[i] = av; be[i] = e * av;
            }
            if (need_mask) {
#pragma unroll
                for (int i = 0; i < 16; ++i) { const bool dead = (k0 + 32 * kb + crow(i, hh) >= tq); a[i] = dead ? 1.0f : a[i]; be[i] = dead ? 0.0f : be[i]; }
            }
            float gp[4], pp[4];
#pragma unroll
            for (int g = 0; g < 4; ++g) { gp[g] = (a[4 * g] * a[4 * g + 1]) * (a[4 * g + 2] * a[4 * g + 3]); pp[g] = __shfl_xor(gp[g], 32); }
            float wv[16];
#pragma unroll
            for (int gi = 0; gi < 4; ++gi) { const int g = 3 - gi;
                float P = hh ? C : C * pp[g];
#pragma unroll
                for (int ei = 0; ei < 4; ++ei) { const int i = 4 * g + 3 - ei; wv[i] = be[i] * P; P *= a[i]; }
                C *= gp[g] * pp[g]; }
            const bf16x8 pf0 = pack8(wv[0], wv[1], wv[2], wv[3], wv[4], wv[5], wv[6], wv[7]);
            const bf16x8 pf1 = pack8(wv[8], wv[9], wv[10], wv[11], wv[12], wv[13], wv[14], wv[15]);
            pv_block(st.o0, st.o1, (unsigned)(size_t)(vbuf + 32 * kb * KV_PITCH) + tr_lane, pf0, pf1);
        }
    }
    st.C = C;
    { const bool done = (k0 <= tq0) && (C < 1e-30f);
      const unsigned long long bal = __ballot(done);
      st.wdone = (bal == ~0ull);
      if (lane == 0) flags[(it & 1) * 8 + w] = st.wdone ? 1u : 0u; }
    if (kt == 0) return true;
    st.it = it + 1; st.kt = kt - 1;
    return false;
}
__device__ __forceinline__ void sb_attn_unit2(LAS unsigned char* lds, const bf16_t* proj, bf16_t* mix, int unit) {
    const int tid = threadIdx.x, lane = tid & 63, w = tid >> 6, r = lane & 31, hh = lane >> 5;
    const int qb = unit & 31, hp = (unit >> 5) % 6, bb = unit / 192;
    const int hs = w >> 2, h = 2 * hp + hs;
    const size_t brow = (size_t)bb * SEQ; const int t0 = 128 * qb, tq0 = t0 + 32 * (w & 3), tq = tq0 + r;
    constexpr int HB_ = 2 * 64 * KV_PITCH;
    bf16x8 qf[4];
    { const bf16_t* qp = proj + (brow + tq) * NP0 + h * 64 + 8 * hh;
#pragma unroll
      for (int s = 0; s < 4; ++s) qf[s] = *(const bf16x8*)(qp + 16 * s); }
    SbState st;
#pragma unroll
    for (int i = 0; i < 16; ++i) { st.o0[i] = 0.f; st.o1[i] = 0.f; }
    st.C = 1.0f; st.wdone = false; st.it = 0; st.kt = 2 * qb + 1;
    const bf16_t* gk[2]; unsigned st_off[2];
#pragma unroll
    for (int i = 0; i < 2; ++i) { const int e = tid + 512 * i, s2 = e >> 9, key = (e >> 3) & 63, c = e & 7;
        gk[i] = proj + (brow + key) * NP0 + 768 + (2 * hp + s2) * 64 + 8 * c; st_off[i] = s2 * HB_ + key * KV_PITCH + c * 16; }
    u32x4 kA[2], vA[2], kB[2], vB[2];
#pragma unroll
    for (int i = 0; i < 2; ++i) { kA[i] = *(const u32x4*)(gk[i] + (size_t)(64 * st.kt) * NP0); vA[i] = *(const u32x4*)(gk[i] + (size_t)(64 * st.kt) * NP0 + 768);
        kB[i] = *(const u32x4*)(gk[i] + (size_t)(64 * (st.kt - 1)) * NP0); vB[i] = *(const u32x4*)(gk[i] + (size_t)(64 * (st.kt - 1)) * NP0 + 768); }
    for (;;) {
        if (sb2_iter(lds, st, kA, vA, gk, st_off, qf, w, lane, tq0)) break;
        if (sb2_iter(lds, st, kB, vB, gk, st_off, qf, w, lane, tq0)) break;
    }
    { bf16_t* op = mix + (brow + tq) * DM + h * 64 + 4 * hh;
#pragma unroll
      for (int g = 0; g < 4; ++g) { u32x2 w0, w1; w0.x = cvt_pk_bf16(st.o0[4 * g], st.o0[4 * g + 1]); w0.y = cvt_pk_bf16(st.o0[4 * g + 2], st.o0[4 * g + 3]);
          w1.x = cvt_pk_bf16(st.o1[4 * g], st.o1[4 * g + 1]); w1.y = cvt_pk_bf16(st.o1[4 * g + 2], st.o1[4 * g + 3]);
          *(u32x2*)(op + 8 * g) = w0; *(u32x2*)(op + 32 + 8 * g) = w1; } }
    __syncthreads();
}

__device__ __forceinline__ void mem_attn_unit(LAS unsigned char* lds, const bf16_t* proj, int ldp, int qoff, const bf16_t* kv, bf16_t* mix, int unit) {
    const int tid = threadIdx.x, lane = tid & 63, w = tid >> 6, r = lane & 31, hh = lane >> 5;
    const int qb = unit & 15, hm = (unit >> 4) & 3, bb = unit >> 6;
    const size_t row = (size_t)bb * SEQ + qb * 256 + 32 * w + r;
    LAS unsigned char* kbuf = lds; LAS unsigned char* vbuf = lds + 256 * KV_PITCH;
    { const bf16_t* g = kv + (size_t)bb * 256 * 1024 + hm * 64;
#pragma unroll
      for (int i = 0; i < 4; ++i) { const int e = tid + 512 * i, key = e >> 3, c = e & 7;
          *(LAS u32x4*)(kbuf + key * KV_PITCH + c * 16) = *(const u32x4*)(g + (size_t)key * 1024 + 8 * c);
          *(LAS u32x4*)(vbuf + key * KV_PITCH + c * 16) = *(const u32x4*)(g + (size_t)key * 1024 + 256 + 8 * c); } }
    bf16x8 qf[4];
    { const bf16_t* qp = proj + row * ldp + qoff + hm * 64 + 8 * hh;
#pragma unroll
      for (int s = 0; s < 4; ++s) qf[s] = *(const bf16x8*)(qp + 16 * s); }
    __syncthreads();
    const float c2 = 0.125f * 1.44269504f;
    float mx = -3.0e38f;
#pragma unroll 1
    for (int kb = 0; kb < 8; ++kb) {
        f32x16 sT;
#pragma unroll
        for (int i = 0; i < 16; ++i) sT[i] = 0.f;
        const LAS unsigned char* ka = kbuf + (32 * kb + r) * KV_PITCH + 16 * hh;
        { bf16x8 af[4];
#pragma unroll
          for (int s = 0; s < 4; ++s) af[s] = *(const LAS bf16x8*)(ka + 32 * s);
          asm volatile("" ::: "memory");
#pragma unroll
          for (int s = 0; s < 4; ++s) sT = MFMA32(af[s], qf[s], sT); }
#pragma unroll
        for (int i = 0; i < 16; ++i) mx = fmaxf(mx, sT[i]);
    }
    mx = fmaxf(mx, __shfl_xor(mx, 32));
    const float mc = mx * c2;
    f32x16 o0, o1;
#pragma unroll
    for (int i = 0; i < 16; ++i) { o0[i] = 0.f; o1[i] = 0.f; }
    float l = 0.f;
    const int i16 = lane & 15, q4 = i16 >> 2, p4 = i16 & 3, blk = (lane >> 4) & 1;
    const unsigned tr_lane = (4 * hh + q4) * KV_PITCH + 32 * blk + 8 * p4;
#pragma unroll 1
    for (int kb = 0; kb < 8; ++kb) {
        f32x16 sT;
#pragma unroll
        for (int i = 0; i < 16; ++i) sT[i] = 0.f;
        const LAS unsigned char* ka = kbuf + (32 * kb + r) * KV_PITCH + 16 * hh;
        { bf16x8 af[4];
#pragma unroll
          for (int s = 0; s < 4; ++s) af[s] = *(const LAS bf16x8*)(ka + 32 * s);
          asm volatile("" ::: "memory");
#pragma unroll
          for (int s = 0; s < 4; ++s) sT = MFMA32(af[s], qf[s], sT); }
        float p[16];
#pragma unroll
        for (int i = 0; i < 16; ++i) { p[i] = __builtin_amdgcn_exp2f(sT[i] * c2 - mc); l += p[i]; }
        const bf16x8 pf0 = pack8(p[0], p[1], p[2], p[3], p[4], p[5], p[6], p[7]);
        const bf16x8 pf1 = pack8(p[8], p[9], p[10], p[11], p[12], p[13], p[14], p[15]);
        pv_block(o0, o1, (unsigned)(size_t)(vbuf + 32 * kb * KV_PITCH) + tr_lane, pf0, pf1);
    }
    l += __shfl_xor(l, 32);
    const float il = 1.0f / l;
    { bf16_t* op = mix + row * DM + 768 + hm * 64 + 4 * hh;
#pragma unroll
      for (int g = 0; g < 4; ++g) { u32x2 w0, w1; w0.x = cvt_pk_bf16(o0[4 * g] * il, o0[4 * g + 1] * il); w0.y = cvt_pk_bf16(o0[4 * g + 2] * il, o0[4 * g + 3] * il);
          w1.x = cvt_pk_bf16(o1[4 * g] * il, o1[4 * g + 1] * il); w1.y = cvt_pk_bf16(o1[4 * g + 2] * il, o1[4 * g + 3] * il);
          *(u32x2*)(op + 8 * g) = w0; *(u32x2*)(op + 32 + 8 * g) = w1; } }
    __syncthreads();
}

__device__ __forceinline__ void tr_read8_nat(unsigned addr, u32x2 (&r)[8]) {
    asm volatile("ds_read_b64_tr_b16 %0, %8 offset:0\n\tds_read_b64_tr_b16 %1, %8 offset:1088\n\tds_read_b64_tr_b16 %2, %8 offset:4352\n\tds_read_b64_tr_b16 %3, %8 offset:5440\n\t"
                 "ds_read_b64_tr_b16 %4, %8 offset:8704\n\tds_read_b64_tr_b16 %5, %8 offset:9792\n\tds_read_b64_tr_b16 %6, %8 offset:13056\n\tds_read_b64_tr_b16 %7, %8 offset:14144"
                 : "=&v"(r[0]), "=&v"(r[1]), "=&v"(r[2]), "=&v"(r[3]), "=&v"(r[4]), "=&v"(r[5]), "=&v"(r[6]), "=&v"(r[7]) : "v"(addr) : "memory");
}
__device__ __forceinline__ void tr_read8_perm(unsigned addr, u32x2 (&r)[8]) {
    asm volatile("ds_read_b64_tr_b16 %0, %8 offset:0\n\tds_read_b64_tr_b16 %1, %8 offset:2176\n\tds_read_b64_tr_b16 %2, %8 offset:4352\n\tds_read_b64_tr_b16 %3, %8 offset:6528\n\t"
                 "ds_read_b64_tr_b16 %4, %8 offset:8704\n\tds_read_b64_tr_b16 %5, %8 offset:10880\n\tds_read_b64_tr_b16 %6, %8 offset:13056\n\tds_read_b64_tr_b16 %7, %8 offset:15232"
                 : "=&v"(r[0]), "=&v"(r[1]), "=&v"(r[2]), "=&v"(r[3]), "=&v"(r[4]), "=&v"(r[5]), "=&v"(r[6]), "=&v"(r[7]) : "v"(addr) : "memory");
}
__device__ __forceinline__ void tr_wait8(u32x2 (&a)[8]) {
    asm volatile("s_waitcnt lgkmcnt(0)" : "+v"(a[0]), "+v"(a[1]), "+v"(a[2]), "+v"(a[3]), "+v"(a[4]), "+v"(a[5]), "+v"(a[6]), "+v"(a[7]) :: "memory");
}
__device__ __forceinline__ void tr_wait16(u32x2 (&a)[8], u32x2 (&b)[8]) {
    asm volatile("s_waitcnt lgkmcnt(0)" : "+v"(a[0]), "+v"(a[1]), "+v"(a[2]), "+v"(a[3]), "+v"(a[4]), "+v"(a[5]), "+v"(a[6]), "+v"(a[7]),
                 "+v"(b[0]), "+v"(b[1]), "+v"(b[2]), "+v"(b[3]), "+v"(b[4]), "+v"(b[5]), "+v"(b[6]), "+v"(b[7]) :: "memory");
}
constexpr int HP = 272;
constexpr int HG_NSEG = 16, HG_CPS = 4;
template <int MODE>
__device__ __forceinline__ void hgrn_seg(LAS unsigned char* lds, const bf16_t* proj, const float* logf, const float* gn, bf16_t* mix, float* segs, float* segd, int bh, int seg) {
    const int tid = threadIdx.x, lane = tid & 63, w = tid >> 6, r = lane & 31, hh = lane >> 5;
    const int bb = bh / 6, h = bh % 6; const size_t base = (size_t)bb * SEQ + (size_t)seg * (64 * HG_CPS);
    constexpr size_t KIND_STRIDE = (size_t)6 * T_TOK * 128; const size_t hbase = (size_t)h * T_TOK + base;
    LAS unsigned char* QT = lds; LAS unsigned char* KT = lds + 17408; LAS unsigned char* QG = lds + 34816; LAS unsigned char* VV = lds + 52224; LAS unsigned char* SP = lds + 69632;
    LAS float* GT = (LAS float*)(lds + 104448); LAS float* EGL = (LAS float*)(lds + 108544); LAS float* EGLR = EGL + 128; LAS float* RP = (LAS float*)(lds + 109568);
    LAS float* GNL = (LAS float*)(lds + 110592);
    if (MODE && tid < 128) GNL[tid] = gn[h * 128 + tid];
    const int tb = w >> 2, dvb = w & 3, cp = lane;
    const int i16 = lane & 15, q4 = i16 >> 2, p4 = i16 & 3, blk = (lane >> 4) & 1;
    const unsigned trc = 32 * blk + 8 * p4;
    float* sptr = segs + ((size_t)(bh * HG_NSEG + seg) * 16384) + (size_t)(w * 2) * 1024 + lane;
    f32x16 S0, S1, o;
#pragma unroll
    for (int i = 0; i < 16; ++i) { S0[i] = MODE ? sptr[i * 64] : 0.f; S1[i] = MODE ? sptr[1024 + i * 64] : 0.f; o[i] = 0.f; }
    f32x2 dtot = (f32x2){0.f, 0.f};
    f32x2 gr[8]; unsigned qr[8], kr[8]; u32x4 vr[2]; u32x2 gwr[4];
#define HG_LOAD_G(c) do { const size_t row0 = hbase + 64 * (c) + 8 * w; \
        _Pragma("unroll") for (int i = 0; i < 8; ++i) gr[i] = *(const f32x2*)(logf + (row0 + i) * 128 + 2 * cp); } while (0)
#define HG_LOAD(c) do { const size_t row0 = hbase + 64 * (c) + 8 * w; \
        _Pragma("unroll") for (int i = 0; i < 8; ++i) { \
            const bf16_t* pr = proj + (row0 + i) * 128 + 2 * cp; if (MODE) qr[i] = *(const unsigned*)pr; kr[i] = *(const unsigned*)(pr + KIND_STRIDE); } \
        _Pragma("unroll") for (int i = 0; i < 2; ++i) { const int e = tid + 512 * i; vr[i] = *(const u32x4*)(proj + 2 * KIND_STRIDE + (hbase + 64 * (c) + (e >> 4)) * 128 + 8 * (e & 15)); } } while (0)
#define HG_GATE(c) do { const size_t row = hbase + 64 * (c) + 32 * tb + r; \
        _Pragma("unroll") for (int g = 0; g < 4; ++g) gwr[g] = *(const u32x2*)(proj + 3 * KIND_STRIDE + row * 128 + 32 * dvb + 8 * g + 4 * hh); } while (0)
#define HG_FINAL(c) do { float tot = (RP[(tb * 4 + 0) * 32 + r] + RP[(tb * 4 + 1) * 32 + r]) + (RP[(tb * 4 + 2) * 32 + r] + RP[(tb * 4 + 3) * 32 + r]); \
        const float rs = 1.0f / sqrtf(tot * (1.f / 128.f) + RMS_EPS); const size_t row = base + 64 * (c) + 32 * tb + r; \
        _Pragma("unroll") for (int g = 0; g < 4; ++g) { const int dv0 = h * 128 + 32 * dvb + 8 * g + 4 * hh; \
            const u32x2 gw = gwr[g]; const f32x4 g4 = *(const LAS f32x4*)(GNL + 32 * dvb + 8 * g + 4 * hh); \
            u32x2 ow; ow.x = cvt_pk_bf16(o[4 * g] * rs * g4[0] * bflo(gw.x), o[4 * g + 1] * rs * g4[1] * bfhi(gw.x)); \
            ow.y = cvt_pk_bf16(o[4 * g + 2] * rs * g4[2] * bflo(gw.y), o[4 * g + 3] * rs * g4[3] * bfhi(gw.y)); \
            *(u32x2*)(mix + row * DM + dv0) = ow; } } while (0)
    HG_LOAD_G(0); HG_LOAD(0);
#pragma unroll 1
    for (int c = 0; c < HG_CPS; ++c) {
        f32x2 gl[8]; gl[0] = gr[0];
#pragma unroll
        for (int i = 1; i < 8; ++i) gl[i] = gl[i - 1] + gr[i];
        *(LAS f32x2*)(GT + w * 128 + 2 * cp) = gl[7];
        if (c + 1 < HG_CPS) HG_LOAD_G(c + 1);
        LDS_BARRIER();
        if (MODE && c > 0) HG_FINAL(c - 1);
        f32x2 pre = (f32x2){0.f, 0.f}, ref = pre, tot2 = pre;
#pragma unroll
        for (int j = 0; j < 8; ++j) { const f32x2 t = *(const LAS f32x2*)(GT + j * 128 + 2 * cp); if (j < w) pre += t; if (j < 4) ref += t; tot2 += t; }
        dtot += tot2;
#pragma unroll
        for (int i = 0; i < 8; ++i) {
            const f32x2 G = pre + gl[i];
            const float k0 = bflo(kr[i]), k1 = bfhi(kr[i]);
            const float ek0 = __expf(fminf(ref[0] - G[0], 80.f)), ek1 = __expf(fminf(ref[1] - G[1], 80.f));
            const unsigned off = (8 * w + i) * HP + 4 * cp;
            *(LAS unsigned*)(KT + off) = cvt_pk_bf16(k0 * ek0, k1 * ek1);
            if (MODE) {
                const float q0 = bflo(qr[i]), q1 = bfhi(qr[i]);
                const float eq0 = __expf(fminf(G[0] - ref[0], 80.f)), eq1 = __expf(fminf(G[1] - ref[1], 80.f));
                const float eg0 = __expf(G[0]), eg1 = __expf(G[1]);
                *(LAS unsigned*)(QT + off) = cvt_pk_bf16(q0 * eq0, q1 * eq1);
                *(LAS unsigned*)(QG + off) = cvt_pk_bf16(q0 * eg0, q1 * eg1);
            }
        }
#pragma unroll
        for (int i = 0; i < 2; ++i) { const int e = tid + 512 * i; *(LAS u32x4*)(VV + (e >> 4) * HP + 16 * (e & 15)) = vr[i]; }
        if (w == 0) { *(LAS f32x2*)(EGL + 2 * cp) = (f32x2){__expf(tot2[0]), __expf(tot2[1])}; *(LAS f32x2*)(EGLR + 2 * cp) = (f32x2){__expf(tot2[0] - ref[0]), __expf(tot2[1] - ref[1])}; }
        if (MODE) {
#pragma unroll
            for (int g = 0; g < 4; ++g) {
                u32x2 a, b; a.x = cvt_pk_bf16(S0[4 * g], S0[4 * g + 1]); a.y = cvt_pk_bf16(S0[4 * g + 2], S0[4 * g + 3]); b.x = cvt_pk_bf16(S1[4 * g], S1[4 * g + 1]); b.y = cvt_pk_bf16(S1[4 * g + 2], S1[4 * g + 3]);
                const unsigned off = (32 * dvb + r) * HP + (64 * tb + 8 * g + 4 * hh) * 2;
                *(LAS u32x2*)(SP + off) = a; *(LAS u32x2*)(SP + off + 64) = b;
            }
            HG_GATE(c);
        }
        if (c + 1 < HG_CPS) HG_LOAD(c + 1);
        LDS_BARRIER();
        const unsigned vbase = (unsigned)(size_t)VV + 64 * dvb + trc, kbase = (unsigned)(size_t)KT + trc;
        if (MODE) {
            bf16x8 pf[2][2], qtf[8];
#pragma unroll
            for (int ks = 0; ks < 8; ++ks) qtf[ks] = *(const LAS bf16x8*)(QT + (32 * tb + r) * HP + 32 * ks + 16 * hh);
#pragma unroll
            for (int sb = 0; sb < 2; ++sb) if (sb <= tb) {
                f32x16 aT;
#pragma unroll
                for (int i = 0; i < 16; ++i) aT[i] = 0.f;
                { bf16x8 af[8];
#pragma unroll
                  for (int ks = 0; ks < 8; ++ks) af[ks] = *(const LAS bf16x8*)(KT + (32 * sb + r) * HP + 32 * ks + 16 * hh);
                  asm volatile("" ::: "memory");
#pragma unroll
                  for (int ks = 0; ks < 8; ++ks) aT = MFMA32(af[ks], qtf[ks], aT); }
                if (sb == tb) {
#pragma unroll
                    for (int i = 0; i < 16; ++i) aT[i] = (crow(i, hh) > r) ? 0.f : aT[i];
                }
                pf[sb][0] = pack8(aT[0], aT[1], aT[2], aT[3], aT[4], aT[5], aT[6], aT[7]);
                pf[sb][1] = pack8(aT[8], aT[9], aT[10], aT[11], aT[12], aT[13], aT[14], aT[15]);
            }
#pragma unroll
            for (int i = 0; i < 16; ++i) o[i] = 0.f;
            { bf16x8 af[8], bfr[8];
#pragma unroll
              for (int ks = 0; ks < 8; ++ks) { af[ks] = *(const LAS bf16x8*)(SP + (32 * dvb + r) * HP + 32 * ks + 16 * hh); bfr[ks] = *(const LAS bf16x8*)(QG + (32 * tb + r) * HP + 32 * ks + 16 * hh); }
              asm volatile("" ::: "memory");
#pragma unroll
              for (int ks = 0; ks < 8; ++ks) o = MFMA32(af[ks], bfr[ks], o); }
            { u32x2 vt[8]; tr_read8_perm(vbase + (4 * hh + q4) * HP, vt); tr_wait8(vt);
              o = MFMA32(as_bf16x8(vt[0], vt[1]), pf[0][0], o); o = MFMA32(as_bf16x8(vt[2], vt[3]), pf[0][1], o);
              if (tb) { o = MFMA32(as_bf16x8(vt[4], vt[5]), pf[1][0], o); o = MFMA32(as_bf16x8(vt[6], vt[7]), pf[1][1], o); } }
            float ss = 0.f;
#pragma unroll
            for (int i = 0; i < 16; ++i) ss += o[i] * o[i];
            ss += __shfl_xor(ss, 32);
            if (hh == 0) RP[(tb * 4 + dvb) * 32 + r] = ss;
        }
        if (MODE == 0 || c + 1 < HG_CPS) {
            u32x2 vf[8], kf[8];
            tr_read8_nat(vbase + (8 * hh + q4) * HP, vf);
            tr_read8_nat(kbase + 128 * tb + (8 * hh + q4) * HP, kf);
            tr_wait16(vf, kf);
#pragma unroll
            for (int j = 0; j < 2; ++j) {
                const int kkb = 2 * tb + j;
                f32x16 M;
#pragma unroll
                for (int i = 0; i < 16; ++i) M[i] = 0.f;
                if (j == 1) { tr_read8_nat(kbase + 128 * tb + 64 + (8 * hh + q4) * HP, kf); tr_wait8(kf); }
#pragma unroll
                for (int ks = 0; ks < 4; ++ks) M = MFMA32(as_bf16x8(kf[2 * ks], kf[2 * ks + 1]), as_bf16x8(vf[2 * ks], vf[2 * ks + 1]), M);
#pragma unroll
                for (int g = 0; g < 4; ++g) { const f32x4 el = *(const LAS f32x4*)(EGL + 32 * kkb + 8 * g + 4 * hh), er = *(const LAS f32x4*)(EGLR + 32 * kkb + 8 * g + 4 * hh);
#pragma unroll
                    for (int e = 0; e < 4; ++e) { if (j == 0) S0[4 * g + e] = el[e] * S0[4 * g + e] + er[e] * M[4 * g + e]; else S1[4 * g + e] = el[e] * S1[4 * g + e] + er[e] * M[4 * g + e]; } }
            }
        }
    }
    __syncthreads();
    if (MODE) { HG_FINAL(HG_CPS - 1); }
    else {
#pragma unroll
        for (int i = 0; i < 16; ++i) { sptr[i * 64] = S0[i]; sptr[1024 + i * 64] = S1[i]; }
        if (w == 0) *(f32x2*)(segd + (size_t)(bh * HG_NSEG + seg) * 128 + 2 * cp) = (f32x2){__expf(dtot[0]), __expf(dtot[1])};
    }
    __syncthreads();
#undef HG_LOAD
#undef HG_LOAD_G
#undef HG_GATE
#undef HG_FINAL
}
__device__ __forceinline__ void hgrn_seg_state(LAS unsigned char* lds, const bf16_t* proj, const float* logf, float* segs, float* segd, int bh, int seg) {
    const int tid = threadIdx.x, lane = tid & 63, w = tid >> 6, hh = lane >> 5, cp = lane;
    const int bb = bh / 6, h = bh % 6;
    constexpr size_t KIND_STRIDE = (size_t)6 * T_TOK * 128; const size_t hbase = (size_t)h * T_TOK + (size_t)bb * SEQ + (size_t)seg * 256;
    LAS unsigned char* KD = lds; LAS unsigned char* VV = lds + 69632; LAS float* GT2 = (LAS float*)(lds + 139264);
    const int tb = w >> 2, dvb = w & 3;
    const int i16 = lane & 15, q4 = i16 >> 2, p4 = i16 & 3, blk = (lane >> 4) & 1;
    const unsigned trc = 32 * blk + 8 * p4;
    { u32x4 vr[8];
#pragma unroll
      for (int i = 0; i < 8; ++i) { const int e = tid + 512 * i; vr[i] = *(const u32x4*)(proj + 2 * KIND_STRIDE + (hbase + (e >> 4)) * 128 + 8 * (e & 15)); }
#pragma unroll
      for (int i = 0; i < 8; ++i) { const int e = tid + 512 * i; *(LAS u32x4*)(VV + (e >> 4) * HP + 16 * (e & 15)) = vr[i]; } }
    f32x2 gl[32]; unsigned kr[32];
    { const size_t row0 = hbase + 32 * w;
#pragma unroll
      for (int i = 0; i < 32; ++i) { gl[i] = *(const f32x2*)(logf + (row0 + i) * 128 + 2 * cp); kr[i] = *(const unsigned*)(proj + KIND_STRIDE + (row0 + i) * 128 + 2 * cp); } }
#pragma unroll
    for (int i = 1; i < 32; ++i) gl[i] = gl[i - 1] + gl[i];
    *(LAS f32x2*)(GT2 + w * 128 + 2 * cp) = gl[31];
    __syncthreads();
    f32x2 pre = (f32x2){0.f, 0.f}, tot = pre;
#pragma unroll
    for (int j = 0; j < 8; ++j) { const f32x2 t = *(const LAS f32x2*)(GT2 + j * 128 + 2 * cp); if (j < w) pre += t; tot += t; }
    const f32x2 rem = tot - pre;
#pragma unroll
    for (int i = 0; i < 32; ++i) {
        const f32x2 d = rem - gl[i];
        const float e0 = __expf(fminf(d[0], 0.f)), e1 = __expf(fminf(d[1], 0.f));
        *(LAS unsigned*)(KD + (32 * w + i) * HP + 4 * cp) = cvt_pk_bf16(bflo(kr[i]) * e0, bfhi(kr[i]) * e1);
    }
    if (w == 0) *(f32x2*)(segd + (size_t)(bh * HG_NSEG + seg) * 128 + 2 * cp) = (f32x2){__expf(tot[0]), __expf(tot[1])};
    __syncthreads();
    f32x16 S0, S1;
#pragma unroll
    for (int i = 0; i < 16; ++i) { S0[i] = 0.f; S1[i] = 0.f; }
    const unsigned vbase = (unsigned)(size_t)VV + 64 * dvb + trc + (8 * hh + q4) * HP, kbase = (unsigned)(size_t)KD + trc + 128 * tb + (8 * hh + q4) * HP;
#pragma unroll 1
    for (int q = 0; q < 4; ++q) {
        u32x2 vf[8], kf0[8], kf1[8];
        tr_read8_nat(vbase + q * 64 * HP, vf); tr_read8_nat(kbase + q * 64 * HP, kf0); tr_read8_nat(kbase + q * 64 * HP + 64, kf1);
        tr_wait16(vf, kf0); tr_wait8(kf1);
#pragma unroll
        for (int ks = 0; ks < 4; ++ks) { S0 = MFMA32(as_bf16x8(kf0[2 * ks], kf0[2 * ks + 1]), as_bf16x8(vf[2 * ks], vf[2 * ks + 1]), S0);
                                         S1 = MFMA32(as_bf16x8(kf1[2 * ks], kf1[2 * ks + 1]), as_bf16x8(vf[2 * ks], vf[2 * ks + 1]), S1); }
    }
    float* sptr = segs + ((size_t)(bh * HG_NSEG + seg) * 16384) + (size_t)(w * 2) * 1024 + lane;
#pragma unroll
    for (int i = 0; i < 16; ++i) { sptr[i * 64] = S0[i]; sptr[1024 + i * 64] = S1[i]; }
    __syncthreads();
}

__device__ __forceinline__ void hgrn_scan(float* segs, const float* segd, int gtid, int nthr) {
    for (int e = gtid; e < 48 * 16384; e += nthr) {
        const int bh = e >> 14, idx = e & 16383, wj = idx >> 10, i = (idx >> 6) & 15, ln = idx & 63;
        const int kk = 32 * (2 * (wj >> 3) + (wj & 1)) + crow(i, ln >> 5);
        float sacc = 0.f;
#pragma unroll 4
        for (int sg = 0; sg < HG_NSEG; ++sg) {
            float* p = segs + (size_t)(bh * HG_NSEG + sg) * 16384 + idx;
            const float L = (sg < HG_NSEG - 1) ? *p : 0.f, d = (sg < HG_NSEG - 1) ? segd[(bh * HG_NSEG + sg) * 128 + kk] : 0.f;
            *p = sacc; sacc = d * sacc + L;
        }
    }
}

#define XB_TMO      128
#define XB_XCNT(j)  (256  + 64 * (j))
#define XB_XSUB(j)  (1280 + 64 * (j))
#define XB_XGEN(j)  (2304 + 64 * (j))
#define XB_TOP      3328
#define XB_TOPGEN   3392
#define XCD_BAR_WORDS 3456
#define XB_SPIN_CAP (1u << 18)
__device__ __forceinline__ unsigned xb_ld(unsigned* p)              { return __hip_atomic_load(p, __ATOMIC_RELAXED, __HIP_MEMORY_SCOPE_AGENT); }
__device__ __forceinline__ unsigned xb_add(unsigned* p, unsigned v) { return __hip_atomic_fetch_add(p, v, __ATOMIC_RELAXED, __HIP_MEMORY_SCOPE_AGENT); }
__device__ __forceinline__ unsigned xb_xcc_id() { return (unsigned)__builtin_amdgcn_s_getreg((3 << 11) | 20) & 0xFu; }
#define XB_SPIN(cond, bar) do { unsigned _sp = 0; while (cond) { __builtin_amdgcn_s_sleep(1); \
    if ((++_sp & 255u) == 0u) { if (xb_ld(&(bar)[XB_TMO])) break; if (_sp > XB_SPIN_CAP) { atomicAdd(&(bar)[XB_TMO], 1u); break; } } } } while (0)
struct XcdBarrier { unsigned* bar; unsigned x; volatile LAS unsigned* st; };
__device__ __forceinline__ XcdBarrier xcd_barrier_post(unsigned* bar, volatile LAS unsigned* st) {
    XcdBarrier b; b.bar = bar; b.x = xb_xcc_id(); b.st = st;
    if (threadIdx.x == 0) (void)xb_add(&bar[XB_XCNT(b.x)], 1u);
    return b;
}
__device__ __forceinline__ void xcd_barrier_complete(unsigned* bar, unsigned x, unsigned& nloc, unsigned& nx) {
    const unsigned G = gridDim.x * gridDim.y * gridDim.z;
    unsigned sum, cnt, mine, sp = 0u;
    for (;;) {
        sum = 0u; cnt = 0u; mine = 0u;
#pragma unroll
        for (unsigned j = 0; j < 16; ++j) { const unsigned c = xb_ld(&bar[XB_XCNT(j)]); sum += c; cnt += (c > 0u) ? 1u : 0u; mine = (j == x) ? c : mine; }
        if (sum == G) break;
        __builtin_amdgcn_s_sleep(1);
        if ((++sp & 255u) == 0u) { if (xb_ld(&bar[XB_TMO])) break; if (sp > XB_SPIN_CAP) { atomicAdd(&bar[XB_TMO], 1u); break; } }
    }
    nloc = mine > 0u ? mine : 1u; nx = cnt > 0u ? cnt : 1u;
}
__device__ __forceinline__ void xcd_barrier(const XcdBarrier& b) {
    asm volatile("s_waitcnt vmcnt(0)" ::: "memory");
    __syncthreads();
    if (threadIdx.x == 0) {
        unsigned* bar = b.bar;
        __builtin_amdgcn_s_waitcnt(0);
        unsigned nloc = b.st[0], nx = b.st[1];
        if (nloc == 0u) { xcd_barrier_complete(bar, b.x, nloc, nx); b.st[0] = nloc; b.st[1] = nx; }
        const unsigned old = xb_add(&bar[XB_XSUB(b.x)], 1u);
        const unsigned gen = old / nloc;
        if (old + 1u == (gen + 1u) * nloc) {
            __builtin_amdgcn_fence(__ATOMIC_RELEASE, "agent");
            asm volatile("s_waitcnt vmcnt(0)" ::: "memory");
            const unsigned og = xb_add(&bar[XB_TOP], 1u);
            const unsigned tg = og / nx;
            if (og + 1u == (tg + 1u) * nx) xb_add(&bar[XB_TOPGEN], 1u);
            else XB_SPIN(xb_ld(&bar[XB_TOPGEN]) == tg, bar);
            __builtin_amdgcn_fence(__ATOMIC_ACQUIRE, "agent");
            xb_add(&bar[XB_XGEN(b.x)], 1u);
            asm volatile("s_waitcnt vmcnt(0)" ::: "memory");
        } else {
            XB_SPIN(xb_ld(&bar[XB_XGEN(b.x)]) == gen, bar);
            __builtin_amdgcn_fence(__ATOMIC_ACQUIRE, "agent");
            asm volatile("s_waitcnt vmcnt(0)" ::: "memory");
        }
    }
    __syncthreads();
}
constexpr size_t OFF_BAR = 98304;

__global__ void __launch_bounds__(512, 2) fwd_kernel(Args args) {
    extern __shared__ __attribute__((aligned(16))) unsigned char lds_raw[];
    LAS unsigned char* lds = (LAS unsigned char*)lds_raw;
    cg::grid_group grid = cg::this_grid();
    const int tid = threadIdx.x, lane = tid & 63, wave = __builtin_amdgcn_readfirstlane(tid >> 6);
    const int G = gridDim.x, bx = blockIdx.x;
    unsigned char* ws = args.ws;
    const float* x = args.in[0]; const float* mem = args.in[1]; const float* w_in_sb = args.in[2]; const float* w_in_hg = args.in[3]; const float* w_mem_kv = args.in[4];
    const float* lower_bounds = args.in[5]; const float* hg_norm_g = args.in[6]; const float* w_out = args.in[7]; const float* ln_mix_g = args.in[8]; const float* ln_mix_b = args.in[9];
    const float* w_up = args.in[10]; const float* w_down = args.in[11]; const float* ln_ffn_g = args.in[12]; const float* ln_ffn_b = args.in[13];
    float* out = args.out;
    bf16_t* WSB = (bf16_t*)(ws + WS_WSB); bf16_t* WHG = (bf16_t*)(ws + WS_WHG); bf16_t* WKV = (bf16_t*)(ws + WS_WKV); bf16_t* WOUT = (bf16_t*)(ws + WS_WOUT);
    bf16_t* WUP = (bf16_t*)(ws + WS_WUP); bf16_t* WDN = (bf16_t*)(ws + WS_WDN); bf16_t* MEMB = (bf16_t*)(ws + WS_MEMB); bf16_t* MEMKV = (bf16_t*)(ws + WS_MEMKV);
    float* ST1 = (float*)(ws + OFF_ST1); float* ST2 = (float*)(ws + OFF_ST2); float* ST3 = (float*)(ws + OFF_ST3);
    bf16_t* UB = (bf16_t*)(ws + WS_UB); bf16_t* MIX = (bf16_t*)(ws + WS_MIX); bf16_t* PROJ = (bf16_t*)(ws + WS_PROJ); float* LOGF = (float*)(ws + WS_LOGF); bf16_t* HB = (bf16_t*)(ws + WS_H);
    float* C1HG = (float*)(ws + OFF_C1HG); float* C2HG = (float*)(ws + OFF_C2HG); float* C1UP0 = (float*)(ws + OFF_C1UP0); float* C2UP0 = (float*)(ws + OFF_C2UP0);
    float* C1UP1 = (float*)(ws + OFF_C1UP1); float* C2UP1 = (float*)(ws + OFF_C2UP1);
    const int lo = args.ph_lo, hi = args.ph_hi;
    volatile LAS unsigned* bst = (volatile LAS unsigned*)(lds + 147392);
    if (tid < 2) bst[tid] = 0u;
    __syncthreads();
    const XcdBarrier gbar = xcd_barrier_post((unsigned*)(ws + OFF_BAR), bst);
    if (lo < 0) grid.sync();
#define GRID_SYNC() xcd_barrier(gbar)
#define IN(k) (lo <= (k) && (k) < hi)
#define SEAM(k) do { if (IN(k) && IN((k) + 1)) GRID_SYNC(); } while (0)
    const int gtid = bx * 512 + tid, nthr = G * 512;

    if (IN(0)) {
        LAS float* scr = (LAS float*)(lds + wave * 16384);
        const int gw = bx * 8 + wave, NGW = G * 8;
        constexpr int I_SB = 16 * (NP0 / 32), I_HG = 16 * (NP1 / 32), I_KV = 16 * (512 / 32), I_OUT = 16 * (1024 / 32), I_UP = 16 * (4096 / 32), I_DN = 64 * (1024 / 32);
                constexpr int N_EARLY = I_SB + 2 * I_KV;
        for (int it = gw; it < N_EARLY; it += NGW) {
            int r = it;
            if (r < I_SB) { p0_transpose_item(w_in_sb, 1024, NP0, WSB, scr, r, lane, nullptr, nullptr, nullptr, nullptr); continue; } r -= I_SB;
            if (r < I_KV) { p0_transpose_item(w_mem_kv, 1024, 512, WKV, scr, r, lane, nullptr, nullptr, nullptr, nullptr); continue; } r -= I_KV;
            p0_transpose_item(w_mem_kv + 1024 * 512, 1024, 512, WKV + 512 * 1024, scr, r, lane, nullptr, nullptr, nullptr, nullptr);
        }
        for (int m = gw; m < T_TOK; m += NGW) row_to_bf16(x + (size_t)m * DM, UB + (size_t)m * DM, lane);
        for (int m = gw; m < 2048; m += NGW) row_to_bf16(mem + (size_t)m * DM, MEMB + (size_t)m * DM, lane);
        __syncthreads();
    }
    SEAM(0);
    if (IN(1)) {
        { pg8::Gemm g{UB, WSB, T_TOK, NP0, 1024}; pg8::StaticOrder S; S.init(T_TOK, NP0, G, bx); EpiBf16Plain E{PROJ, NP0}; pg8::gemm_phase(lds, g, S, E); }
        if (bx < 32 || G <= 64) { pg8::Gemm g{MEMB, WKV, 2048, 1024, 1024}; pg8::StaticOrder S; S.init(2048, 1024, G, bx); EpiBf16Plain E{MEMKV, 1024}; pg8::gemm_phase(lds, g, S, E); }
        if (bx >= 32 || G <= 64) {
            LAS float* scr = (LAS float*)(lds + wave * 16384);
            const int nb0 = (G <= 64) ? 0 : 32, gw = (bx - nb0) * 8 + wave, NGW = (G - nb0) * 8;
            constexpr int I_HG = 16 * (NP1 / 32), I_OUT = 16 * (1024 / 32), I_UP = 16 * (4096 / 32), I_DN = 64 * (1024 / 32);
            constexpr int N_LATE = I_HG + 2 * I_OUT + 2 * I_UP + 2 * I_DN;
            for (int it = gw; it < N_LATE; it += NGW) {
                int r = it;
                if (r < I_HG) { p0_transpose_item(w_in_hg, 1024, NP1, WHG, scr, r, lane, ln_ffn_g, ln_ffn_b, C1HG, C2HG); continue; } r -= I_HG;
                if (r < I_OUT) { p0_transpose_item(w_out, 1024, 1024, WOUT, scr, r, lane, nullptr, nullptr, nullptr, nullptr); continue; } r -= I_OUT;
                if (r < I_OUT) { p0_transpose_item(w_out + 1024 * 1024, 1024, 1024, WOUT + 1024 * 1024, scr, r, lane, nullptr, nullptr, nullptr, nullptr); continue; } r -= I_OUT;
                if (r < I_UP) { p0_transpose_item(w_up, 1024, 4096, WUP, scr, r, lane, ln_mix_g, ln_mix_b, C1UP0, C2UP0); continue; } r -= I_UP;
                if (r < I_UP) { p0_transpose_item(w_up + 1024 * 4096, 1024, 4096, WUP + 4096 * 1024, scr, r, lane, ln_mix_g + 1024, ln_mix_b + 1024, C1UP1, C2UP1); continue; } r -= I_UP;
                if (r < I_DN) { p0_transpose_item(w_down, 4096, 1024, WDN, scr, r, lane, nullptr, nullptr, nullptr, nullptr); continue; } r -= I_DN;
                p0_transpose_item(w_down + 4096 * 1024, 4096, 1024, WDN + 1024 * 4096, scr, r, lane, nullptr, nullptr, nullptr, nullptr);
            }
            __syncthreads();
        }
    }
    SEAM(1);
    if (IN(2)) {
        for (int u = bx; u < 8 * 6 * 32; u += G) sb_attn_unit2(lds, PROJ, MIX, u);
        for (int u = bx; u < 512; u += G) mem_attn_unit(lds, PROJ, NP0, 2304, MEMKV, MIX, u);
    }
    SEAM(2);
    if (IN(3)) { pg8::Gemm g{MIX, WOUT, T_TOK, 1024, 1024}; pg8::StaticOrder S; S.init(T_TOK, 1024, G, bx);
        EpiResid<0, 1> E{x, UB, nullptr, ST1, nullptr, nullptr}; pg8::gemm_phase(lds, g, S, E); }
    SEAM(3);
    if (IN(4)) { pg8::Gemm g{UB, WUP, T_TOK, 4096, 1024}; pg8::StaticOrder S; S.init(T_TOK, 4096, G, bx);
        EpiUp E{HB, ST1, C1UP0, C2UP0}; pg8::gemm_phase(lds, g, S, E); }
    SEAM(4);
    if (IN(5)) { pg8::Gemm g{HB, WDN, T_TOK, 1024, 4096}; pg8::StaticOrder S; S.init(T_TOK, 1024, G, bx);
        EpiResid<1, 1> E{nullptr, UB, ST1, ST2, ln_mix_g, ln_mix_b}; pg8::gemm_phase(lds, g, S, E); }
    SEAM(5);
    if (IN(6)) { pg8::Gemm g{UB, WHG, T_TOK, NP1, 1024}; pg8::StaticOrder S; S.init(T_TOK, NP1, G, bx);
        EpiProj1 E{PROJ, LOGF, ST2, C1HG, C2HG, lower_bounds}; pg8::gemm_phase(lds, g, S, E); }
    SEAM(6);
    if (IN(7)) {
        float* SEGS = out; float* SEGD = out + (size_t)768 * 16384;
        for (int u = bx; u < 720 + 512; u += G) {
            if (u < 720) hgrn_seg_state(lds, PROJ, LOGF, SEGS, SEGD, u / 15, u % 15);
            else mem_attn_unit(lds, PROJ + (size_t)4 * 6 * T_TOK * 128, 256, 0, MEMKV + 512, MIX, u - 720);
        }
        GRID_SYNC();
        hgrn_scan(SEGS, SEGD, gtid, nthr);
        GRID_SYNC();
        for (int u = bx; u < 768; u += G) hgrn_seg<1>(lds, PROJ, LOGF, hg_norm_g, MIX, SEGS, SEGD, u >> 4, u & 15);
    }
    SEAM(7);
    if (IN(8)) { pg8::Gemm g{MIX, WOUT + 1024 * 1024, T_TOK, 1024, 1024}; pg8::StaticOrder S; S.init(T_TOK, 1024, G, bx);
        EpiResid<1, 1> E{nullptr, UB, ST2, ST3, ln_ffn_g, ln_ffn_b}; pg8::gemm_phase(lds, g, S, E); }
    SEAM(8);
    if (IN(9)) { pg8::Gemm g{UB, WUP + 4096 * 1024, T_TOK, 4096, 1024}; pg8::StaticOrder S; S.init(T_TOK, 4096, G, bx);
        EpiUp E{HB, ST3, C1UP1, C2UP1}; pg8::gemm_phase(lds, g, S, E); }
    SEAM(9);
    if (IN(10)) { pg8::Gemm g{HB, WDN + 1024 * 4096, T_TOK, 1024, 4096}; pg8::StaticOrder S; S.init(T_TOK, 1024, G, bx);
        EpiResid<1, 0> E{nullptr, UB, ST3, nullptr, ln_mix_g + 1024, ln_mix_b + 1024}; pg8::gemm_phase(lds, g, S, E); }
    SEAM(10);
    if (IN(11)) {
        const int gw = bx * 8 + wave, NGW = G * 8;
        const float* gg = ln_ffn_g + 1024; const float* bb = ln_ffn_b + 1024;
        for (int m = gw; m < T_TOK; m += NGW) {
            const u32x4* ur = (const u32x4*)(UB + (size_t)m * DM) + lane;
            f32x4 v[4]; float s = 0.f;
#pragma unroll
            for (int j = 0; j < 2; ++j) { const u32x4 wv = ur[64 * j];
                v[2 * j] = (f32x4){bflo(wv.x), bfhi(wv.x), bflo(wv.y), bfhi(wv.y)}; v[2 * j + 1] = (f32x4){bflo(wv.z), bfhi(wv.z), bflo(wv.w), bfhi(wv.w)}; }
#pragma unroll
            for (int j = 0; j < 4; ++j) s += (v[j][0] + v[j][1]) + (v[j][2] + v[j][3]);
            const float mean = wave_sum(s) * (1.f / DM); float s2 = 0.f;
#pragma unroll
            for (int j = 0; j < 4; ++j) { v[j] = v[j] - mean; s2 += (v[j][0] * v[j][0] + v[j][1] * v[j][1]) + (v[j][2] * v[j][2] + v[j][3] * v[j][3]); }
            const float rstd = 1.f / sqrtf(wave_sum(s2) * (1.f / DM) + LN_EPS);
#pragma unroll
            for (int j = 0; j < 4; ++j) { const int col = 512 * (j >> 1) + 8 * lane + 4 * (j & 1);
                const f32x4 g4 = *(const f32x4*)(gg + col), b4 = *(const f32x4*)(bb + col); *(f32x4*)(out + (size_t)m * DM + col) = v[j] * rstd * g4 + b4; }
        }
    }
#undef IN
#undef SEAM
}

constexpr int N_PHASES = 12;
extern "C" void kernel_launch(void* const* d_in, const int* in_sizes, int n_in, void* d_out, int out_size, void* d_ws, size_t ws_size, hipStream_t stream) {
    static int grid = 0;
    if (grid == 0) {
        if (n_in != 14 || in_sizes[0] != T_TOK * DM || out_size != T_TOK * DM || ws_size < WS_END) { fprintf(stderr, "kernel_launch: unexpected shapes (n_in %d, ws %zu)\n", n_in, ws_size); grid = -1; return; }
        int dev = 0, cus = 0, per_cu = 0;
        hipGetDevice(&dev); hipDeviceGetAttribute(&cus, hipDeviceAttributeMultiprocessorCount, dev);
        if (hipFuncSetAttribute((const void*)fwd_kernel, hipFuncAttributeMaxDynamicSharedMemorySize, LDS_BYTES) != hipSuccess) { fprintf(stderr, "kernel_launch: hipFuncSetAttribute failed\n"); grid = -1; return; }
        if (hipOccupancyMaxActiveBlocksPerMultiprocessor(&per_cu, (const void*)fwd_kernel, 512, LDS_BYTES) != hipSuccess || per_cu < 1) { fprintf(stderr, "kernel_launch: occupancy query says %d\n", per_cu); per_cu = 1; }
        (void)hipGetLastError();
        grid = cus * 1;
    }
    if (grid < 0) return;
    hipMemsetAsync((char*)d_ws + WS_CTL, 0, CTL_ZERO_BYTES, stream);
    Args a{};
    for (int i = 0; i < 14; ++i) a.in[i] = (const float*)d_in[i];
    a.out = (float*)d_out; a.ws = (unsigned char*)d_ws;
    a.ph_lo = 0; a.ph_hi = N_PHASES;
    void* kargs[] = {&a};
    hipError_t e = hipLaunchCooperativeKernel((const void*)fwd_kernel, dim3(grid), dim3(512), kargs, LDS_BYTES, stream);
    if (e != hipSuccess) fprintf(stderr, "cooperative launch failed: %s (grid %d)\n", hipGetErrorString(e), grid);
}
```

```cpp
#include <hip/hip_runtime.h>
#include <hip/hip_cooperative_groups.h>
#include <cstdio>
namespace cg = cooperative_groups;

#define LAS __attribute__((address_space(3)))
typedef unsigned short bf16_t;
typedef short bf16x8 __attribute__((ext_vector_type(8)));
typedef float f32x4 __attribute__((ext_vector_type(4)));
typedef float f32x2 __attribute__((ext_vector_type(2)));
typedef unsigned u32x4 __attribute__((ext_vector_type(4)));
typedef unsigned u32x2 __attribute__((ext_vector_type(2)));

constexpr int T_TOK = 32768, SEQ = 4096, DM = 1024, DFF = 4096;
constexpr int NP0 = 2560, NP1 = 3328;
constexpr float ALPHA = 1.41421356237f, LN_EPS = 1e-5f, RMS_EPS = 1e-6f;

constexpr size_t MiB = 1u << 20;
constexpr size_t WS_CTL = 0, CTL_ZERO_BYTES = 1024 * 1024;
constexpr size_t OFF_ST1 = 131072, OFF_ST2 = 131072 + 262144, OFF_ST3 = 131072 + 2 * 262144;
constexpr size_t OFF_C1HG = 0, OFF_C2HG = 16384, OFF_C1UP0 = 32768, OFF_C2UP0 = 49152, OFF_C1UP1 = 65536, OFF_C2UP1 = 81920;
constexpr size_t WS_WSB = 1 * MiB, WS_WHG = 6 * MiB, WS_WKV = 13 * MiB, WS_WOUT = 15 * MiB, WS_WUP = 19 * MiB, WS_WDN = 35 * MiB;
constexpr size_t WS_MEMB = 51 * MiB, WS_MEMKV = 55 * MiB;
constexpr size_t WS_UB = 68 * MiB, WS_MIX = 132 * MiB, WS_PROJ = 196 * MiB, WS_LOGF = 404 * MiB, WS_H = 196 * MiB, WS_END = 500 * MiB;
static_assert(WS_PROJ + (size_t)T_TOK * NP1 * 2 <= WS_LOGF, "proj");
static_assert(WS_LOGF + (size_t)T_TOK * 768 * 4 <= WS_END, "logf");
static_assert(WS_H + (size_t)T_TOK * DFF * 2 <= WS_END, "h");

constexpr int LDS_BYTES = 147456;

__device__ __forceinline__ unsigned cvt_pk_bf16(float lo, float hi) { unsigned r; asm volatile("v_cvt_pk_bf16_f32 %0, %1, %2" : "=v"(r) : "v"(lo), "v"(hi)); return r; }
__device__ __forceinline__ float bf2f(bf16_t b) { return __uint_as_float(((unsigned)b) << 16); }
__device__ __forceinline__ float bflo(unsigned w) { return __uint_as_float(w << 16); }
__device__ __forceinline__ float bfhi(unsigned w) { return __uint_as_float(w & 0xffff0000u); }
__device__ __forceinline__ bf16_t f2bf(float f) { return (bf16_t)(cvt_pk_bf16(f, 0.f) & 0xffffu); }
__device__ __forceinline__ float wave_sum(float v) {
#pragma unroll
    for (int o = 1; o < 64; o <<= 1) v += __shfl_xor(v, o);
    return v;
}

namespace pg8 {
constexpr int BM = 256, BK = 64, HALF = 128, HTB = HALF * BK * 2, STAGE_BYTES = 8 * HTB, NXCD = 8, WGM = 4;
__host__ __device__ __forceinline__ int lds_byte(int r, int c) { const int st = (r >> 4) * 2 + (c >> 5), rr = r & 15, cc = c & 31, ob = rr * 64 + cc * 2; return st * 1024 + (ob ^ (((ob >> 9) & 1) << 5)); }
__host__ __device__ __forceinline__ void stage_rc(int b, int& R, int& C) { const int st = b / 1024, sb = b % 1024, swz = sb ^ (((sb >> 9) & 1) << 5); R = (st >> 1) * 16 + swz / 64; C = (st & 1) * 32 + (swz % 64) / 2; }
__host__ __device__ __forceinline__ int perm32(int rho) { const int n = rho >> 4, i = rho & 15; return 8 * (i >> 2) + 4 * n + (i & 3); }
struct Unit { int pm, pn; };
struct Gemm { const bf16_t* A; const bf16_t* Bt; int M, N, K; };
struct StaticOrder {
    int nM, nN, nwg, G, c;
    __host__ __device__ void init(int M, int N, int G_, int c_) { nM = M / BM; nN = N / BM; nwg = nM * nN; G = G_; c = c_; }
    __host__ __device__ bool next(int i, Unit& u) const {
        const long L = (long)i * G + c; if (L >= nwg) return false;
        int wgid = (int)L; { const int q = nwg / NXCD, r = nwg % NXCD, xcd = wgid % NXCD, off = wgid / NXCD; wgid = (xcd < r ? xcd * (q + 1) : r * (q + 1) + (xcd - r) * q) + off; }
        const int nig = WGM * nN, gid = wgid / nig, fm = gid * WGM, gsz = (nM - fm) < WGM ? (nM - fm) : WGM;
        u.pm = fm + ((wgid % nig) % gsz); u.pn = (wgid % nig) / gsz; return true;
    }
};

template <class Epi, class Sched, bool ALIGN_EPI = true, bool SP2 = true>
__device__ __forceinline__ void gemm_phase(LAS unsigned char* lds, const Gemm g, const Sched& S, const Epi& E) {
    const int tid = threadIdx.x, wid = __builtin_amdgcn_readfirstlane(tid >> 6), lane = tid & 63, wr = wid >> 2, wc = wid & 3, fr = lane & 15, fq = lane >> 4;
    const int K = g.K, nt = K / BK;
    unsigned voffA[2], voffB[2];
#pragma unroll
    for (int i = 0; i < 2; ++i) { int R, C; stage_rc(tid * 16 + i * 8192, R, C); const int Rb = Epi::PERM ? ((R & ~31) + perm32(R & 31)) : R;
        voffA[i] = (unsigned)(R * K + C) * 2u; voffB[i] = (unsigned)(Rb * K + C) * 2u; }
    const size_t kstep = (size_t)(BK * 2);
    const size_t hstep = (size_t)HALF * K * 2;
    const size_t tstep = 2 * hstep;
    const unsigned ldsw = (unsigned)wid * 1024u;
    const int aoff = lds_byte(wr * 64 + fr, fq * 8), boff = lds_byte(wc * 32 + fr, fq * 8);
#define PG8_SA(b, h) (((b) * 2 + (h)) * HTB)
#define PG8_SB(b, h) ((4 + (b) * 2 + (h)) * HTB)
#define PG8_STAGE(bufoff, gbase, voff) do { _Pragma("unroll") for (int _i = 0; _i < 2; ++_i) \
        __builtin_amdgcn_global_load_lds((const unsigned*)((const char*)(gbase) + (voff)[_i]), (LAS unsigned*)(lds + (bufoff) + ldsw + _i * 8192), 16, 0, 0); } while (0)
#define PG8_LDA(dst, b, h) do { _Pragma("unroll") for (int m = 0; m < 4; ++m) _Pragma("unroll") for (int k = 0; k < 2; ++k) dst[m][k] = *(const LAS bf16x8*)(lds + PG8_SA(b, h) + aoff + m * 2048 + k * 1024); } while (0)
#define PG8_LDB(dst, b, h) do { _Pragma("unroll") for (int n = 0; n < 2; ++n) _Pragma("unroll") for (int k = 0; k < 2; ++k) dst[n][k] = *(const LAS bf16x8*)(lds + PG8_SB(b, h) + boff + n * 2048 + k * 1024); } while (0)
#define PG8_MMA(ai, bj, At, Bt) do { __builtin_amdgcn_s_setprio(1); _Pragma("unroll") for (int m = 0; m < 4; ++m) _Pragma("unroll") for (int n = 0; n < 2; ++n) _Pragma("unroll") for (int k = 0; k < 2; ++k) \
        acc[ai][bj][m][n] = __builtin_amdgcn_mfma_f32_16x16x32_bf16(Bt[n][k], At[m][k], acc[ai][bj][m][n], 0, 0, 0); __builtin_amdgcn_s_setprio(0); } while (0)
#define PG8_WAIT_V(n) asm volatile("s_waitcnt vmcnt(" #n ")" ::: "memory")
#define PG8_WAIT_L(n) asm volatile("s_waitcnt lgkmcnt(" #n ")" ::: "memory")
#define PG8_BAR __builtin_amdgcn_s_barrier()
#define PG8_SCHED __builtin_amdgcn_sched_barrier(0)
    Unit cur, nxt; int ui = 0;
    if (!S.next(0, cur)) return;
    f32x4 acc[2][2][4][2];
#pragma unroll
    for (int a = 0; a < 2; ++a)
#pragma unroll
        for (int b = 0; b < 2; ++b)
#pragma unroll
            for (int m = 0; m < 4; ++m)
#pragma unroll
                for (int n = 0; n < 2; ++n) acc[a][b][m][n] = (f32x4){0.f, 0.f, 0.f, 0.f};
    bf16x8 At[4][2], B0[2][2], B1[2][2];
    const char* cA = (const char*)g.A + (size_t)cur.pm * tstep; const char* cB = (const char*)g.Bt + (size_t)cur.pn * tstep;
    if constexpr (SP2) {
        PG8_STAGE(PG8_SB(0, 0), cB, voffB); PG8_STAGE(PG8_SB(0, 1), cB + hstep, voffB); PG8_STAGE(PG8_SA(0, 0), cA, voffA); PG8_STAGE(PG8_SA(0, 1), cA + hstep, voffA);
        if (wr == 1) PG8_BAR;
        PG8_WAIT_V(2); PG8_BAR;
        PG8_STAGE(PG8_SB(1, 0), cB + kstep, voffB); PG8_STAGE(PG8_SA(1, 0), cA + kstep, voffA); PG8_STAGE(PG8_SB(1, 1), cB + hstep + kstep, voffB);
        PG8_WAIT_V(6); PG8_BAR;
    } else {
        PG8_STAGE(PG8_SB(0, 0), cB, voffB); PG8_STAGE(PG8_SA(0, 0), cA, voffA); PG8_STAGE(PG8_SB(0, 1), cB + hstep, voffB); PG8_STAGE(PG8_SA(0, 1), cA + hstep, voffA);
        if (wr == 1) PG8_BAR;
        PG8_WAIT_V(4); PG8_BAR;
        PG8_STAGE(PG8_SB(1, 0), cB + kstep, voffB); PG8_STAGE(PG8_SA(1, 0), cA + kstep, voffA); PG8_STAGE(PG8_SB(1, 1), cB + hstep + kstep, voffB);
        PG8_WAIT_V(6); PG8_BAR;
    }
    for (;;) {
        const bool has_next = S.next(ui + 1, nxt);
        const char* nA = has_next ? (const char*)g.A + (size_t)nxt.pm * tstep : cA; const char* nB = has_next ? (const char*)g.Bt + (size_t)nxt.pn * tstep : cB;
        for (int t = 0; t < nt; t += 2) {
            const bool last = (t == nt - 2);
            const char* a1 = cA + (size_t)(t + 1) * kstep;
            const char* a2 = last ? nA : cA + (size_t)(t + 2) * kstep; const char* b2 = last ? nB : cB + (size_t)(t + 2) * kstep;
            const char* a3 = a2 + kstep; const char* b3 = b2 + kstep;
            if constexpr (SP2) {
            PG8_LDB(B0, 0, 0); PG8_LDB(B1, 0, 1); PG8_SCHED; PG8_LDA(At, 0, 0); PG8_STAGE(PG8_SA(1, 1), a1 + hstep, voffA);
            PG8_WAIT_V(8); PG8_WAIT_L(0); PG8_BAR; PG8_MMA(0, 0, At, B0); PG8_MMA(0, 1, At, B1); PG8_BAR; PG8_SCHED;
            PG8_LDA(At, 0, 1); PG8_STAGE(PG8_SB(0, 0), b2, voffB); PG8_STAGE(PG8_SB(0, 1), b2 + hstep, voffB); PG8_STAGE(PG8_SA(0, 0), a2, voffA);
            PG8_WAIT_V(8); PG8_WAIT_L(0); PG8_BAR; PG8_MMA(1, 0, At, B0); PG8_MMA(1, 1, At, B1); PG8_BAR; PG8_SCHED;
            PG8_LDB(B0, 1, 0); PG8_LDB(B1, 1, 1); PG8_SCHED; PG8_LDA(At, 1, 0); PG8_STAGE(PG8_SA(0, 1), a2 + hstep, voffA);
            PG8_WAIT_V(8); PG8_WAIT_L(0); PG8_BAR; PG8_MMA(0, 0, At, B0); PG8_MMA(0, 1, At, B1); PG8_BAR; PG8_SCHED;
            PG8_LDA(At, 1, 1); PG8_STAGE(PG8_SB(1, 0), b3, voffB); PG8_STAGE(PG8_SB(1, 1), b3 + hstep, voffB); PG8_STAGE(PG8_SA(1, 0), a3, voffA);
            PG8_WAIT_V(8); PG8_WAIT_L(0); PG8_BAR; PG8_MMA(1, 0, At, B0); PG8_MMA(1, 1, At, B1); PG8_BAR; PG8_SCHED;
            } else {
            PG8_LDB(B0, 0, 0); PG8_SCHED; PG8_LDA(At, 0, 0); PG8_STAGE(PG8_SA(1, 1), a1 + hstep, voffA);
            PG8_WAIT_L(8); PG8_BAR; PG8_WAIT_L(0); PG8_MMA(0, 0, At, B0); PG8_BAR; PG8_SCHED;
            PG8_LDB(B1, 0, 1); PG8_STAGE(PG8_SB(0, 0), b2, voffB);
            PG8_BAR; PG8_WAIT_L(0); PG8_MMA(0, 1, At, B1); PG8_BAR;
            PG8_LDA(At, 0, 1); PG8_STAGE(PG8_SA(0, 0), a2, voffA);
            PG8_BAR; PG8_WAIT_L(0); PG8_MMA(1, 0, At, B0); PG8_BAR; PG8_SCHED;
            PG8_STAGE(PG8_SB(0, 1), b2 + hstep, voffB);
            PG8_WAIT_V(6); PG8_BAR; PG8_MMA(1, 1, At, B1); PG8_BAR;
            PG8_LDB(B0, 1, 0); PG8_SCHED; PG8_LDA(At, 1, 0); PG8_STAGE(PG8_SA(0, 1), a2 + hstep, voffA);
            PG8_WAIT_L(8); PG8_BAR; PG8_WAIT_L(0); PG8_MMA(0, 0, At, B0); PG8_BAR; PG8_SCHED;
            PG8_LDB(B1, 1, 1); PG8_STAGE(PG8_SB(1, 0), b3, voffB);
            PG8_BAR; PG8_WAIT_L(0); PG8_MMA(0, 1, At, B1); PG8_BAR;
            PG8_LDA(At, 1, 1); PG8_STAGE(PG8_SA(1, 0), a3, voffA);
            PG8_BAR; PG8_WAIT_L(0); PG8_MMA(1, 0, At, B0); PG8_BAR; PG8_SCHED;
            PG8_STAGE(PG8_SB(1, 1), b3 + hstep, voffB);
            PG8_WAIT_V(6); PG8_BAR; PG8_MMA(1, 1, At, B1); PG8_BAR;
            }
        }
        if constexpr (ALIGN_EPI) { if (wr == 0) PG8_BAR; }
        E(acc, cur, wr, wc, fr, fq);
        if (!has_next) break;
#pragma unroll
        for (int a = 0; a < 2; ++a)
#pragma unroll
            for (int b = 0; b < 2; ++b)
#pragma unroll
                for (int m = 0; m < 4; ++m)
#pragma unroll
                    for (int n = 0; n < 2; ++n) acc[a][b][m][n] = (f32x4){0.f, 0.f, 0.f, 0.f};
        cur = nxt; cA = nA; cB = nB; ++ui;
        if constexpr (ALIGN_EPI) { if (wr == 1) PG8_BAR; }
    }
    PG8_WAIT_V(0);
    if constexpr (!ALIGN_EPI) { if (wr == 0) PG8_BAR; }
    PG8_BAR;
#undef PG8_SA
#undef PG8_SB
#undef PG8_STAGE
#undef PG8_LDA
#undef PG8_LDB
#undef PG8_MMA
#undef PG8_WAIT_V
#undef PG8_WAIT_L
#undef PG8_BAR
#undef PG8_SCHED
}
}

typedef f32x4 AccT[2][2][4][2];

__device__ __forceinline__ void mean_rstd(const f32x2 sv, float& mean, float& rstd) {
    mean = sv[0] * (1.f / DM);
    rstd = 1.0f / sqrtf(fmaxf(sv[1] * (1.f / DM) - mean * mean, 0.f) + LN_EPS);
}
__device__ __forceinline__ void stat_add(float* st, int row, float s1, float s2) {
    (void)__hip_atomic_fetch_add(st + 2 * (size_t)row, s1, __ATOMIC_RELAXED, __HIP_MEMORY_SCOPE_AGENT);
    (void)__hip_atomic_fetch_add(st + 2 * (size_t)row + 1, s2, __ATOMIC_RELAXED, __HIP_MEMORY_SCOPE_AGENT);
}

#define AT(T, base, byteoff) (*(T*)((char*)(base) + (size_t)(unsigned)(byteoff)))
#define ATC(T, base, byteoff) (*(const T*)((const char*)(base) + (size_t)(unsigned)(byteoff)))

struct EpiBf16Plain {
    static constexpr bool PERM = true;
    bf16_t* O; int ldc; unsigned qmask; float qscale;
    __device__ __forceinline__ void operator()(const AccT& acc, const pg8::Unit& u, int wr, int wc, int fr, int fq) const {
        const int row0 = u.pm * 256 + wr * 64 + fr, col0 = u.pn * 256 + wc * 32 + 8 * fq;
        const float sc = ((qmask >> u.pn) & 1u) ? qscale : 1.0f;
        const unsigned rstride = (unsigned)ldc * 2u;
#pragma unroll
        for (int ai = 0; ai < 2; ++ai)
#pragma unroll
            for (int m = 0; m < 4; ++m) { const unsigned off = (unsigned)(row0 + ai * 128 + m * 16) * rstride + (unsigned)col0 * 2u;
#pragma unroll
                for (int bj = 0; bj < 2; ++bj) { const f32x4 v0 = acc[ai][bj][m][0] * sc, v1 = acc[ai][bj][m][1] * sc;
                    u32x4 w; w.x = cvt_pk_bf16(v0[0], v0[1]); w.y = cvt_pk_bf16(v0[2], v0[3]); w.z = cvt_pk_bf16(v1[0], v1[1]); w.w = cvt_pk_bf16(v1[2], v1[3]);
                    AT(u32x4, O, off + bj * 256) = w; } }
    }
};

template <int MODE, int WSTATS> struct EpiResid {
    static constexpr bool PERM = true;
    const float* xin; bf16_t* ub; const float* stats_in; float* stats_out; const float* g; const float* b;
    __device__ __forceinline__ void operator()(const AccT& acc, const pg8::Unit& u, int wr, int wc, int fr, int fq) const {
        const int row0 = u.pm * 256 + wr * 64 + fr, col0 = u.pn * 256 + wc * 32 + 8 * fq;
        f32x4 gv[2][2], bv[2][2]; f32x2 sv[8];
        if (MODE == 1) {
#pragma unroll
            for (int k = 0; k < 8; ++k) sv[k] = ATC(f32x2, stats_in, (unsigned)(row0 + (k >> 2) * 128 + (k & 3) * 16) * 8u);
#pragma unroll
            for (int bj = 0; bj < 2; ++bj)
#pragma unroll
                for (int n = 0; n < 2; ++n) { gv[bj][n] = ATC(f32x4, g, (unsigned)(col0 + bj * 128 + 4 * n) * 4u); bv[bj][n] = ATC(f32x4, b, (unsigned)(col0 + bj * 128 + 4 * n) * 4u); }
        }
        u32x4 rwn[2][2];
        if (MODE == 1) {
#pragma unroll
            for (int mm = 0; mm < 2; ++mm)
#pragma unroll
                for (int bj = 0; bj < 2; ++bj) rwn[mm][bj] = ATC(u32x4, ub, ((unsigned)(row0 + mm * 16) * (unsigned)DM + (unsigned)(col0 + bj * 128)) * 2u);
        }
#pragma unroll
        for (int bt = 0; bt < 4; ++bt) {
            const int ai = bt >> 1, mp = bt & 1;
            f32x4 rx[2][2][2]; u32x4 rw[2][2];
            if (MODE == 1) {
#pragma unroll
                for (int mm = 0; mm < 2; ++mm)
#pragma unroll
                    for (int bj = 0; bj < 2; ++bj) rw[mm][bj] = rwn[mm][bj];
                if (bt < 3) {
                    const int ai2 = (bt + 1) >> 1, mp2 = (bt + 1) & 1;
#pragma unroll
                    for (int mm = 0; mm < 2; ++mm)
#pragma unroll
                        for (int bj = 0; bj < 2; ++bj) rwn[mm][bj] = ATC(u32x4, ub, ((unsigned)(row0 + ai2 * 128 + (2 * mp2 + mm) * 16) * (unsigned)DM + (unsigned)(col0 + bj * 128)) * 2u);
                }
            } else {
#pragma unroll
                for (int mm = 0; mm < 2; ++mm)
#pragma unroll
                    for (int bj = 0; bj < 2; ++bj) {
                        const unsigned eoff = (unsigned)(row0 + ai * 128 + (2 * mp + mm) * 16) * (unsigned)DM + (unsigned)(col0 + bj * 128);
                        rx[mm][bj][0] = ATC(f32x4, xin, eoff * 4u); rx[mm][bj][1] = ATC(f32x4, xin, eoff * 4u + 16u);
                    }
            }
#pragma unroll
            for (int mm = 0; mm < 2; ++mm) {
                const int m = 2 * mp + mm, row = row0 + ai * 128 + m * 16;
                float mu = 0.f, rs = 1.f;
                if (MODE == 1) mean_rstd(sv[ai * 4 + m], mu, rs);
                float s1 = 0.f, s2 = 0.f;
#pragma unroll
                for (int bj = 0; bj < 2; ++bj) {
                    f32x4 r0, r1;
                    if (MODE == 1) { const u32x4 wv = rw[mm][bj];
                        r0 = (f32x4){bflo(wv.x), bfhi(wv.x), bflo(wv.y), bfhi(wv.y)}; r1 = (f32x4){bflo(wv.z), bfhi(wv.z), bflo(wv.w), bfhi(wv.w)};
                        r0 = (r0 - mu) * rs * gv[bj][0] + bv[bj][0]; r1 = (r1 - mu) * rs * gv[bj][1] + bv[bj][1]; }
                    else { r0 = rx[mm][bj][0]; r1 = rx[mm][bj][1]; }
                    const f32x4 o0 = r0 * ALPHA + acc[ai][bj][m][0], o1 = r1 * ALPHA + acc[ai][bj][m][1];
                    u32x4 w; w.x = cvt_pk_bf16(o0[0], o0[1]); w.y = cvt_pk_bf16(o0[2], o0[3]); w.z = cvt_pk_bf16(o1[0], o1[1]); w.w = cvt_pk_bf16(o1[2], o1[3]);
                    AT(u32x4, ub, ((unsigned)row * (unsigned)DM + (unsigned)(col0 + bj * 128)) * 2u) = w;
                    if (WSTATS) {
                        s1 += ((o0[0] + o0[1]) + (o0[2] + o0[3])) + ((o1[0] + o1[1]) + (o1[2] + o1[3]));
                        s2 += ((o0[0] * o0[0] + o0[1] * o0[1]) + (o0[2] * o0[2] + o0[3] * o0[3])) + ((o1[0] * o1[0] + o1[1] * o1[1]) + (o1[2] * o1[2] + o1[3] * o1[3])); }
                }
                if (WSTATS) {
                    s1 += __shfl_xor(s1, 16); s2 += __shfl_xor(s2, 16); s1 += __shfl_xor(s1, 32); s2 += __shfl_xor(s2, 32);
                    if (fq == 0) stat_add(stats_out, row, s1, s2); }
            }
        }
    }
};

struct EpiUp {
    static constexpr bool PERM = true;
    bf16_t* O; const float* stats_in; const float* c1; const float* c2;
    __device__ __forceinline__ void operator()(const AccT& acc, const pg8::Unit& u, int wr, int wc, int fr, int fq) const {
        const int row0 = u.pm * 256 + wr * 64 + fr, col0 = u.pn * 256 + wc * 32 + 8 * fq;
        f32x2 sv[8];
#pragma unroll
        for (int k = 0; k < 8; ++k) sv[k] = ATC(f32x2, stats_in, (unsigned)(row0 + (k >> 2) * 128 + (k & 3) * 16) * 8u);
#pragma unroll
        for (int bj = 0; bj < 2; ++bj) {
            const f32x4 c10 = ATC(f32x4, c1, (unsigned)(col0 + bj * 128) * 4u), c11 = ATC(f32x4, c1, (unsigned)(col0 + bj * 128 + 4) * 4u);
            const f32x4 c20 = ATC(f32x4, c2, (unsigned)(col0 + bj * 128) * 4u), c21 = ATC(f32x4, c2, (unsigned)(col0 + bj * 128 + 4) * 4u);
#pragma unroll
            for (int ai = 0; ai < 2; ++ai)
#pragma unroll
                for (int m = 0; m < 4; ++m) {
                    const int row = row0 + ai * 128 + m * 16;
                    float mean, rstd; mean_rstd(sv[ai * 4 + m], mean, rstd);
                    f32x4 v0 = (acc[ai][bj][m][0] - mean * c10) * rstd + c20;
                    f32x4 v1 = (acc[ai][bj][m][1] - mean * c11) * rstd + c21;
#pragma unroll
                    for (int j = 0; j < 4; ++j) { const float a = fmaxf(v0[j], 0.f), c = fmaxf(v1[j], 0.f); v0[j] = a * a; v1[j] = c * c; }
                    u32x4 w; w.x = cvt_pk_bf16(v0[0], v0[1]); w.y = cvt_pk_bf16(v0[2], v0[3]); w.z = cvt_pk_bf16(v1[0], v1[1]); w.w = cvt_pk_bf16(v1[2], v1[3]);
                    AT(u32x4, O, ((unsigned)row * (unsigned)DFF + (unsigned)(col0 + bj * 128)) * 2u) = w;
                }
        }
    }
};

struct EpiProj1 {
    static constexpr bool PERM = true;
    bf16_t* O; float* logf; const float* stats_in; const float* c1; const float* c2; const float* lbin;
    __device__ __forceinline__ void operator()(const AccT& acc, const pg8::Unit& u, int wr, int wc, int fr, int fq) const {
        const int row0 = u.pm * 256 + wr * 64 + fr, col0 = u.pn * 256 + wc * 32 + 8 * fq;
        const int kind = u.pn / 3;
        f32x2 sv[8];
#pragma unroll
        for (int k = 0; k < 8; ++k) sv[k] = ATC(f32x2, stats_in, (unsigned)(row0 + (k >> 2) * 128 + (k & 3) * 16) * 8u);
#pragma unroll
        for (int bj = 0; bj < 2; ++bj) {
            f32x4 c1v[2], c2v[2], lbv[2];
#pragma unroll
            for (int n = 0; n < 2; ++n) { c1v[n] = ATC(f32x4, c1, (unsigned)(col0 + bj * 128 + 4 * n) * 4u); c2v[n] = ATC(f32x4, c2, (unsigned)(col0 + bj * 128 + 4 * n) * 4u); lbv[n] = (f32x4){0.f, 0.f, 0.f, 0.f}; }
            if (kind == 1) {
#pragma unroll
                for (int n = 0; n < 2; ++n) {
                    const unsigned j0 = (unsigned)(col0 - 768 + bj * 128 + 4 * n);
                    const f32x4 l0 = ATC(f32x4, lbin, j0 * 4u), l1 = ATC(f32x4, lbin, (768u + j0) * 4u);
#pragma unroll
                    for (int j = 0; j < 4; ++j) { const float mx = fmaxf(l0[j], l1[j]), e0 = __expf(l0[j] - mx), e1 = __expf(l1[j] - mx), sm = e0 + e1, p0 = e0 / sm, p1 = e1 / sm; lbv[n][j] = (p0 + p1) - p0; }
                }
            }
#pragma unroll
            for (int ai = 0; ai < 2; ++ai)
#pragma unroll
                for (int m = 0; m < 4; ++m) {
                    const int row = row0 + ai * 128 + m * 16;
                    float mean, rstd; mean_rstd(sv[ai * 4 + m], mean, rstd);
                    f32x4 v[2];
                    v[0] = (acc[ai][bj][m][0] - mean * c1v[0]) * rstd + c2v[0];
                    v[1] = (acc[ai][bj][m][1] - mean * c1v[1]) * rstd + c2v[1];
                    if (kind == 1) {
                        const unsigned cf = (unsigned)(col0 - 768 + bj * 128);
                        const unsigned loff = ((cf >> 7) * (unsigned)(T_TOK * 128) + (unsigned)row * 128u + (cf & 127u)) * 4u;
#pragma unroll
                        for (int n = 0; n < 2; ++n) { f32x4 lf;
#pragma unroll
                            for (int j = 0; j < 4; ++j) { const float z = fminf(fmaxf(v[n][j], -80.f), 80.f), t = __expf(-z), sg = 1.0f / (1.0f + t), lb = lbv[n][j];
                                lf[j] = __logf(lb + (1.0f - lb) * sg); v[n][j] = (1.0f - lb) * (t * sg); }
                            AT(f32x4, logf, loff + 16u * n) = lf; }
                    } else if (kind == 3) {
#pragma unroll
                        for (int n = 0; n < 2; ++n)
#pragma unroll
                            for (int j = 0; j < 4; ++j) { const float z = fminf(fmaxf(v[n][j], -80.f), 80.f); v[n][j] = v[n][j] / (1.0f + __expf(-z)); }
                    } else if (kind == 4) { v[0] = v[0] * (0.125f * 1.44269504f); v[1] = v[1] * (0.125f * 1.44269504f); }
                    u32x4 w; w.x = cvt_pk_bf16(v[0][0], v[0][1]); w.y = cvt_pk_bf16(v[0][2], v[0][3]); w.z = cvt_pk_bf16(v[1][0], v[1][1]); w.w = cvt_pk_bf16(v[1][2], v[1][3]);
                    const unsigned cik = (unsigned)(col0 + bj * 128 - kind * 768);
                    const unsigned eoff = (kind < 4) ? (unsigned)kind * (unsigned)(6 * T_TOK * 128) + (cik >> 7) * (unsigned)(T_TOK * 128) + (unsigned)row * 128u + (cik & 127u)
                                                     : 4u * (unsigned)(6 * T_TOK * 128) + (unsigned)row * 256u + cik;
                    AT(u32x4, O, eoff * 2u) = w;
                }
        }
    }
};

#define LDS_WAIT() asm volatile("s_waitcnt lgkmcnt(0)" ::: "memory")
#define LDS_BARRIER() asm volatile("s_waitcnt lgkmcnt(0)\n\ts_barrier" ::: "memory")
__device__ __forceinline__ void p0_transpose_item(const float* W, int K, int N, bf16_t* WT, LAS float* scr, int item, int lane,
                                                  const float* g, const float* b, float* c1, float* c2) {
    const int nblk = N / 32, kb = item / nblk, nb = item % nblk, k0 = 64 * kb, n0 = 32 * nb;
    { f32x4 t[8];
#pragma unroll
      for (int i = 0; i < 8; ++i) t[i] = *(const f32x4*)(W + (size_t)(k0 + 8 * i + (lane >> 3)) * N + n0 + 4 * (lane & 7));
#pragma unroll
      for (int i = 0; i < 8; ++i) { LAS float* d = scr + (8 * i + (lane >> 3)) * 33 + 4 * (lane & 7); d[0] = t[i][0]; d[1] = t[i][1]; d[2] = t[i][2]; d[3] = t[i][3]; } }
    LDS_WAIT(); asm volatile("" ::: "memory");
    const int c = lane & 7;
    float gk[8], bk[8];
#pragma unroll
    for (int e = 0; e < 8; ++e) { gk[e] = g ? g[k0 + 8 * c + e] : 1.f; bk[e] = g ? b[k0 + 8 * c + e] : 0.f; }
#pragma unroll
    for (int j = 0; j < 4; ++j) { const int n = (lane >> 3) + 8 * j; const LAS float* s = scr + (8 * c) * 33 + n;
        float w[8], p2 = 0.f;
#pragma unroll
        for (int e = 0; e < 8; ++e) { const float x = s[e * 33]; w[e] = x * gk[e]; p2 += bk[e] * x; }
        u32x4 o; o.x = cvt_pk_bf16(w[0], w[1]); o.y = cvt_pk_bf16(w[2], w[3]); o.z = cvt_pk_bf16(w[4], w[5]); o.w = cvt_pk_bf16(w[6], w[7]);
        *(u32x4*)(WT + (size_t)(n0 + n) * K + k0 + 8 * c) = o;
        if (g) {
            float p1 = ((bflo(o.x) + bfhi(o.x)) + (bflo(o.y) + bfhi(o.y))) + ((bflo(o.z) + bfhi(o.z)) + (bflo(o.w) + bfhi(o.w)));
            p1 += __shfl_xor(p1, 1); p2 += __shfl_xor(p2, 1); p1 += __shfl_xor(p1, 2); p2 += __shfl_xor(p2, 2); p1 += __shfl_xor(p1, 4); p2 += __shfl_xor(p2, 4);
            if (c == 0) { atomicAdd(c1 + n0 + n, p1); atomicAdd(c2 + n0 + n, p2); }
        }
    }
    LDS_WAIT(); asm volatile("" ::: "memory");
}
__device__ __forceinline__ void row_to_bf16(const float* xrow, bf16_t* orow, int lane) {
    const f32x4* xr = (const f32x4*)xrow + lane; u32x2* o8 = (u32x2*)orow + lane;
#pragma unroll
    for (int j = 0; j < 4; ++j) { const f32x4 v = xr[64 * j]; u32x2 w; w.x = cvt_pk_bf16(v[0], v[1]); w.y = cvt_pk_bf16(v[2], v[3]); o8[64 * j] = w; }
}

struct Args { const float* in[14]; float* out; unsigned char* ws; int ph_lo, ph_hi; };

typedef float f32x16 __attribute__((ext_vector_type(16)));
#define MFMA32(a, b, c) __builtin_amdgcn_mfma_f32_32x32x16_bf16((a), (b), (c), 0, 0, 0)
constexpr int KV_PITCH = 144;
template <int O0, int O1, int O2, int O3>
__device__ __forceinline__ void tr_read4(unsigned addr, u32x2& r0, u32x2& r1, u32x2& r2, u32x2& r3) {
    asm volatile("ds_read_b64_tr_b16 %0, %4 offset:%5\n\tds_read_b64_tr_b16 %1, %4 offset:%6\n\tds_read_b64_tr_b16 %2, %4 offset:%7\n\tds_read_b64_tr_b16 %3, %4 offset:%8\n\ts_waitcnt lgkmcnt(0)"
                 : "=&v"(r0), "=&v"(r1), "=&v"(r2), "=&v"(r3) : "v"(addr), "n"(O0), "n"(O1), "n"(O2), "n"(O3) : "memory");
}
__device__ __forceinline__ bf16x8 pack8(float x0, float x1, float x2, float x3, float x4, float x5, float x6, float x7) {
    u32x4 p;
    asm volatile("v_cvt_pk_bf16_f32 %0, %4, %5\n\tv_cvt_pk_bf16_f32 %1, %6, %7\n\tv_cvt_pk_bf16_f32 %2, %8, %9\n\tv_cvt_pk_bf16_f32 %3, %10, %11\n\ts_nop 1"
                 : "=&v"(p[0]), "=&v"(p[1]), "=&v"(p[2]), "=&v"(p[3]) : "v"(x0), "v"(x1), "v"(x2), "v"(x3), "v"(x4), "v"(x5), "v"(x6), "v"(x7));
    return __builtin_bit_cast(bf16x8, p);
}
__device__ __forceinline__ bf16x8 as_bf16x8(u32x2 lo, u32x2 hi) { u32x4 p; p.x = lo.x; p.y = lo.y; p.z = hi.x; p.w = hi.y; return __builtin_bit_cast(bf16x8, p); }
__device__ __forceinline__ void pv_block(f32x16& o0, f32x16& o1, unsigned vaddr, bf16x8 pf0, bf16x8 pf1) {
    u32x2 a, b, c, d;
    tr_read4<0, 8 * KV_PITCH, 64, 8 * KV_PITCH + 64>(vaddr, a, b, c, d);
    o0 = MFMA32(as_bf16x8(a, b), pf0, o0); o1 = MFMA32(as_bf16x8(c, d), pf0, o1);
    tr_read4<16 * KV_PITCH, 24 * KV_PITCH, 16 * KV_PITCH + 64, 24 * KV_PITCH + 64>(vaddr, a, b, c, d);
    o0 = MFMA32(as_bf16x8(a, b), pf1, o0); o1 = MFMA32(as_bf16x8(c, d), pf1, o1);
}
__device__ __forceinline__ int crow(int i, int hh) { return (i & 3) + 8 * (i >> 2) + 4 * hh; }

struct SbState { f32x16 o0, o1; float C; bool wdone; int it, kt; };
__device__ __forceinline__ bool sb2_iter(LAS unsigned char* lds, SbState& st, u32x4 (&kreg)[2], u32x4 (&vreg)[2], const bf16_t* const (&gk)[2], const unsigned (&st_off)[2],
                                         const bf16x8 (&qf)[4], int w, int lane, int tq0) {
    constexpr int HB_ = 2 * 64 * KV_PITCH, BUF_ = 2 * HB_;
    const int r = lane & 31, hh = lane >> 5, hs = w >> 2, tq = tq0 + r, it = st.it, kt = st.kt;
    LAS unsigned* flags = (LAS unsigned*)(lds + 2 * BUF_);
    LAS unsigned char* buf = lds + (it & 1) * BUF_;
#pragma unroll
    for (int i = 0; i < 2; ++i) { *(LAS u32x4*)(buf + st_off[i]) = kreg[i]; *(LAS u32x4*)(buf + st_off[i] + 64 * KV_PITCH) = vreg[i]; }
    LDS_BARRIER();
    if (it > 0) { bool all = true;
#pragma unroll
        for (int i = 0; i < 8; ++i) all = all && (flags[((it - 1) & 1) * 8 + i] != 0u);
        if (all) return true; }
    if (kt >= 2) {
#pragma unroll
        for (int i = 0; i < 2; ++i) { kreg[i] = *(const u32x4*)(gk[i] + (size_t)(64 * (kt - 2)) * NP0); vreg[i] = *(const u32x4*)(gk[i] + (size_t)(64 * (kt - 2)) * NP0 + 768); } }
    const int k0 = 64 * kt;
    LAS unsigned char* kbuf = buf + hs * HB_; LAS unsigned char* vbuf = kbuf + 64 * KV_PITCH;
    const int i16 = lane & 15, q4 = i16 >> 2, p4 = i16 & 3, blk = (lane >> 4) & 1;
    const unsigned tr_lane = (4 * hh + q4) * KV_PITCH + 32 * blk + 8 * p4;
    float C = st.C;
    if (k0 <= tq0 && !st.wdone) {
        const bool need_mask = (k0 + 64 > tq0);
#pragma unroll
        for (int kbi = 0; kbi < 2; ++kbi) { const int kb = 1 - kbi;
            f32x16 sT;
#pragma unroll
            for (int i = 0; i < 16; ++i) sT[i] = 0.f;
            const LAS unsigned char* ka = kbuf + (32 * kb + r) * KV_PITCH + 16 * hh;
            { bf16x8 af[4];
#pragma unroll
              for (int s = 0; s < 4; ++s) af[s] = *(const LAS bf16x8*)(ka + 32 * s);
              asm volatile("" ::: "memory");
#pragma unroll
              for (int s = 0; s < 4; ++s) sT = MFMA32(af[s], qf[s], sT); }
            float a[16], be[16];
#pragma unroll
            for (int i = 0; i < 16; ++i) {
                const float z2 = fminf(sT[i], 115.f);
                const float e = __builtin_amdgcn_exp2f(z2), av = __builtin_amdgcn_rcpf(1.0f + e);
                a[i] = av; be[i] = e * av;
            }
            if (need_mask) {
#pragma unroll
                for (int i = 0; i < 16; ++i) { const bool dead = (k0 + 32 * kb + crow(i, hh) >= tq); a[i] = dead ? 1.0f : a[i]; be[i] = dead ? 0.0f : be[i]; }
            }
            float gp[4], pp[4];
#pragma unroll
            for (int g = 0; g < 4; ++g) { gp[g] = (a[4 * g] * a[4 * g + 1]) * (a[4 * g + 2] * a[4 * g + 3]); pp[g] = __shfl_xor(gp[g], 32); }
            float wv[16];
#pragma unroll
            for (int gi = 0; gi < 4; ++gi) { const int g = 3 - gi;
                float P = hh ? C : C * pp[g];
#pragma unroll
                for (int ei = 0; ei < 4; ++ei) { const int i = 4 * g + 3 - ei; wv[i] = be[i] * P; P *= a[i]; }
                C *= gp[g] * pp[g]; }
            const bf16x8 pf0 = pack8(wv[0], wv[1], wv[2], wv[3], wv[4], wv[5], wv[6], wv[7]);
            const bf16x8 pf1 = pack8(wv[8], wv[9], wv[10], wv[11], wv[12], wv[13], wv[14], wv[15]);
            pv_block(st.o0, st.o1, (unsigned)(size_t)(vbuf + 32 * kb * KV_PITCH) + tr_lane, pf0, pf1);
        }
    }
    st.C = C;
    { const bool done = (k0 <= tq0) && (C < 1e-30f);
      const unsigned long long bal = __ballot(done);
      st.wdone = (bal == ~0ull);
      if (lane == 0) flags[(it & 1) * 8 + w] = st.wdone ? 1u : 0u; }
    if (kt == 0) return true;
    st.it = it + 1; st.kt = kt - 1;
    return false;
}
__device__ __forceinline__ void sb_attn_unit2(LAS unsigned char* lds, const bf16_t* proj, bf16_t* mix, int unit) {
    const int tid = threadIdx.x, lane = tid & 63, w = tid >> 6, r = lane & 31, hh = lane >> 5;
    const int qb = unit & 31, hp = (unit >> 5) % 6, bb = unit / 192;
    const int hs = w >> 2, h = 2 * hp + hs;
    const size_t brow = (size_t)bb * SEQ; const int t0 = 128 * qb, tq0 = t0 + 32 * (w & 3), tq = tq0 + r;
    constexpr int HB_ = 2 * 64 * KV_PITCH;
    bf16x8 qf[4];
    { const bf16_t* qp = proj + (brow + tq) * NP0 + h * 64 + 8 * hh;
#pragma unroll
      for (int s = 0; s < 4; ++s) qf[s] = *(const bf16x8*)(qp + 16 * s); }
    SbState st;
#pragma unroll
    for (int i = 0; i < 16; ++i) { st.o0[i] = 0.f; st.o1[i] = 0.f; }
    st.C = 1.0f; st.wdone = false; st.it = 0; st.kt = 2 * qb + 1;
    const bf16_t* gk[2]; unsigned st_off[2];
#pragma unroll
    for (int i = 0; i < 2; ++i) { const int e = tid + 512 * i, s2 = e >> 9, key = (e >> 3) & 63, c = e & 7;
        gk[i] = proj + (brow + key) * NP0 + 768 + (2 * hp + s2) * 64 + 8 * c; st_off[i] = s2 * HB_ + key * KV_PITCH + c * 16; }
    u32x4 kA[2], vA[2], kB[2], vB[2];
#pragma unroll
    for (int i = 0; i < 2; ++i) { kA[i] = *(const u32x4*)(gk[i] + (size_t)(64 * st.kt) * NP0); vA[i] = *(const u32x4*)(gk[i] + (size_t)(64 * st.kt) * NP0 + 768);
        kB[i] = *(const u32x4*)(gk[i] + (size_t)(64 * (st.kt - 1)) * NP0); vB[i] = *(const u32x4*)(gk[i] + (size_t)(64 * (st.kt - 1)) * NP0 + 768); }
    for (;;) {
        if (sb2_iter(lds, st, kA, vA, gk, st_off, qf, w, lane, tq0)) break;
        if (sb2_iter(lds, st, kB, vB, gk, st_off, qf, w, lane, tq0)) break;
    }
    { bf16_t* op = mix + (brow + tq) * DM + h * 64 + 4 * hh;
#pragma unroll
      for (int g = 0; g < 4; ++g) { u32x2 w0, w1; w0.x = cvt_pk_bf16(st.o0[4 * g], st.o0[4 * g + 1]); w0.y = cvt_pk_bf16(st.o0[4 * g + 2], st.o0[4 * g + 3]);
          w1.x = cvt_pk_bf16(st.o1[4 * g], st.o1[4 * g + 1]); w1.y = cvt_pk_bf16(st.o1[4 * g + 2], st.o1[4 * g + 3]);
          *(u32x2*)(op + 8 * g) = w0; *(u32x2*)(op + 32 + 8 * g) = w1; } }
    __syncthreads();
}

__device__ __forceinline__ void mem_attn_unit(LAS unsigned char* lds, const bf16_t* proj, int ldp, int qoff, const bf16_t* kv, bf16_t* mix, int unit) {
    const int tid = threadIdx.x, lane = tid & 63, w = tid >> 6, r = lane & 31, hh = lane >> 5;
    const int qb = unit & 15, hm = (unit >> 4) & 3, bb = unit >> 6;
    const size_t row = (size_t)bb * SEQ + qb * 256 + 32 * w + r;
    LAS unsigned char* kbuf = lds; LAS unsigned char* vbuf = lds + 256 * KV_PITCH;
    { const bf16_t* g = kv + (size_t)bb * 256 * 1024 + hm * 64;
#pragma unroll
      for (int i = 0; i < 4; ++i) { const int e = tid + 512 * i, key = e >> 3, c = e & 7;
          *(LAS u32x4*)(kbuf + key * KV_PITCH + c * 16) = *(const u32x4*)(g + (size_t)key * 1024 + 8 * c);
          *(LAS u32x4*)(vbuf + key * KV_PITCH + c * 16) = *(const u32x4*)(g + (size_t)key * 1024 + 256 + 8 * c); } }
    bf16x8 qf[4];
    { const bf16_t* qp = proj + row * ldp + qoff + hm * 64 + 8 * hh;
#pragma unroll
      for (int s = 0; s < 4; ++s) qf[s] = *(const bf16x8*)(qp + 16 * s); }
    __syncthreads();
    float mx = -3.0e38f;
#pragma unroll 1
    for (int kb = 0; kb < 8; ++kb) {
        f32x16 sT;
#pragma unroll
        for (int i = 0; i < 16; ++i) sT[i] = 0.f;
        const LAS unsigned char* ka = kbuf + (32 * kb + r) * KV_PITCH + 16 * hh;
        { bf16x8 af[4];
#pragma unroll
          for (int s = 0; s < 4; ++s) af[s] = *(const LAS bf16x8*)(ka + 32 * s);
          asm volatile("" ::: "memory");
#pragma unroll
          for (int s = 0; s < 4; ++s) sT = MFMA32(af[s], qf[s], sT); }
#pragma unroll
        for (int i = 0; i < 16; ++i) mx = fmaxf(mx, sT[i]);
    }
    mx = fmaxf(mx, __shfl_xor(mx, 32));
    f32x16 o0, o1;
#pragma unroll
    for (int i = 0; i < 16; ++i) { o0[i] = 0.f; o1[i] = 0.f; }
    float l = 0.f;
    const int i16 = lane & 15, q4 = i16 >> 2, p4 = i16 & 3, blk = (lane >> 4) & 1;
    const unsigned tr_lane = (4 * hh + q4) * KV_PITCH + 32 * blk + 8 * p4;
#pragma unroll 1
    for (int kb = 0; kb < 8; ++kb) {
        f32x16 sT;
#pragma unroll
        for (int i = 0; i < 16; ++i) sT[i] = 0.f;
        const LAS unsigned char* ka = kbuf + (32 * kb + r) * KV_PITCH + 16 * hh;
        { bf16x8 af[4];
#pragma unroll
          for (int s = 0; s < 4; ++s) af[s] = *(const LAS bf16x8*)(ka + 32 * s);
          asm volatile("" ::: "memory");
#pragma unroll
          for (int s = 0; s < 4; ++s) sT = MFMA32(af[s], qf[s], sT); }
        float p[16];
#pragma unroll
        for (int i = 0; i < 16; ++i) { p[i] = __builtin_amdgcn_exp2f(sT[i] - mx); l += p[i]; }
        const bf16x8 pf0 = pack8(p[0], p[1], p[2], p[3], p[4], p[5], p[6], p[7]);
        const bf16x8 pf1 = pack8(p[8], p[9], p[10], p[11], p[12], p[13], p[14], p[15]);
        pv_block(o0, o1, (unsigned)(size_t)(vbuf + 32 * kb * KV_PITCH) + tr_lane, pf0, pf1);
    }
    l += __shfl_xor(l, 32);
    const float il = 1.0f / l;
    { bf16_t* op = mix + row * DM + 768 + hm * 64 + 4 * hh;
#pragma unroll
      for (int g = 0; g < 4; ++g) { u32x2 w0, w1; w0.x = cvt_pk_bf16(o0[4 * g] * il, o0[4 * g + 1] * il); w0.y = cvt_pk_bf16(o0[4 * g + 2] * il, o0[4 * g + 3] * il);
          w1.x = cvt_pk_bf16(o1[4 * g] * il, o1[4 * g + 1] * il); w1.y = cvt_pk_bf16(o1[4 * g + 2] * il, o1[4 * g + 3] * il);
          *(u32x2*)(op + 8 * g) = w0; *(u32x2*)(op + 32 + 8 * g) = w1; } }
    __syncthreads();
}

__device__ __forceinline__ void tr_read8_nat(unsigned addr, u32x2 (&r)[8]) {
    asm volatile("ds_read_b64_tr_b16 %0, %8 offset:0\n\tds_read_b64_tr_b16 %1, %8 offset:1088\n\tds_read_b64_tr_b16 %2, %8 offset:4352\n\tds_read_b64_tr_b16 %3, %8 offset:5440\n\t"
                 "ds_read_b64_tr_b16 %4, %8 offset:8704\n\tds_read_b64_tr_b16 %5, %8 offset:9792\n\tds_read_b64_tr_b16 %6, %8 offset:13056\n\tds_read_b64_tr_b16 %7, %8 offset:14144"
                 : "=&v"(r[0]), "=&v"(r[1]), "=&v"(r[2]), "=&v"(r[3]), "=&v"(r[4]), "=&v"(r[5]), "=&v"(r[6]), "=&v"(r[7]) : "v"(addr) : "memory");
}
__device__ __forceinline__ void tr_read8_perm(unsigned addr, u32x2 (&r)[8]) {
    asm volatile("ds_read_b64_tr_b16 %0, %8 offset:0\n\tds_read_b64_tr_b16 %1, %8 offset:2176\n\tds_read_b64_tr_b16 %2, %8 offset:4352\n\tds_read_b64_tr_b16 %3, %8 offset:6528\n\t"
                 "ds_read_b64_tr_b16 %4, %8 offset:8704\n\tds_read_b64_tr_b16 %5, %8 offset:10880\n\tds_read_b64_tr_b16 %6, %8 offset:13056\n\tds_read_b64_tr_b16 %7, %8 offset:15232"
                 : "=&v"(r[0]), "=&v"(r[1]), "=&v"(r[2]), "=&v"(r[3]), "=&v"(r[4]), "=&v"(r[5]), "=&v"(r[6]), "=&v"(r[7]) : "v"(addr) : "memory");
}
__device__ __forceinline__ void tr_wait8(u32x2 (&a)[8]) {
    asm volatile("s_waitcnt lgkmcnt(0)" : "+v"(a[0]), "+v"(a[1]), "+v"(a[2]), "+v"(a[3]), "+v"(a[4]), "+v"(a[5]), "+v"(a[6]), "+v"(a[7]) :: "memory");
}
__device__ __forceinline__ void tr_wait16(u32x2 (&a)[8], u32x2 (&b)[8]) {
    asm volatile("s_waitcnt lgkmcnt(0)" : "+v"(a[0]), "+v"(a[1]), "+v"(a[2]), "+v"(a[3]), "+v"(a[4]), "+v"(a[5]), "+v"(a[6]), "+v"(a[7]),
                 "+v"(b[0]), "+v"(b[1]), "+v"(b[2]), "+v"(b[3]), "+v"(b[4]), "+v"(b[5]), "+v"(b[6]), "+v"(b[7]) :: "memory");
}
constexpr int HP = 272;
constexpr int HG_NSEG = 16, HG_CPS = 4;
template <int MODE>
__device__ __forceinline__ void hgrn_seg(LAS unsigned char* lds, const bf16_t* proj, const float* logf, const float* gn, bf16_t* mix, float* segs, float* segd, int bh, int seg) {
    const int tid = threadIdx.x, lane = tid & 63, w = tid >> 6, r = lane & 31, hh = lane >> 5;
    const int bb = bh / 6, h = bh % 6; const size_t base = (size_t)bb * SEQ + (size_t)seg * (64 * HG_CPS);
    constexpr size_t KIND_STRIDE = (size_t)6 * T_TOK * 128; const size_t hbase = (size_t)h * T_TOK + base;
    LAS unsigned char* QT = lds; LAS unsigned char* KT = lds + 17408; LAS unsigned char* QG = lds + 34816; LAS unsigned char* VV = lds + 52224; LAS unsigned char* SP = lds + 69632;
    LAS float* GT = (LAS float*)(lds + 104448); LAS float* EGL = (LAS float*)(lds + 108544); LAS float* EGLR = EGL + 128; LAS float* RP = (LAS float*)(lds + 109568);
    LAS float* GNL = (LAS float*)(lds + 110592);
    if (MODE && tid < 128) GNL[tid] = gn[h * 128 + tid];
    const int tb = w >> 2, dvb = w & 3, cp = lane;
    const int i16 = lane & 15, q4 = i16 >> 2, p4 = i16 & 3, blk = (lane >> 4) & 1;
    const unsigned trc = 32 * blk + 8 * p4;
    float* sptr = segs + ((size_t)(bh * HG_NSEG + seg) * 16384) + (size_t)(w * 2) * 1024 + lane;
    f32x16 S0, S1, o;
#pragma unroll
    for (int i = 0; i < 16; ++i) { S0[i] = MODE ? sptr[i * 64] : 0.f; S1[i] = MODE ? sptr[1024 + i * 64] : 0.f; o[i] = 0.f; }
    f32x2 dtot = (f32x2){0.f, 0.f};
    f32x2 gr[8]; unsigned qr[8], kr[8]; u32x4 vr[2]; u32x2 gwr[4];
#define HG_LOAD_G(c) do { const size_t row0 = hbase + 64 * (c) + 8 * w; \
        _Pragma("unroll") for (int i = 0; i < 8; ++i) gr[i] = *(const f32x2*)(logf + (row0 + i) * 128 + 2 * cp); } while (0)
#define HG_LOAD(c) do { const size_t row0 = hbase + 64 * (c) + 8 * w; \
        _Pragma("unroll") for (int i = 0; i < 8; ++i) { \
            const bf16_t* pr = proj + (row0 + i) * 128 + 2 * cp; if (MODE) qr[i] = *(const unsigned*)pr; kr[i] = *(const unsigned*)(pr + KIND_STRIDE); } \
        _Pragma("unroll") for (int i = 0; i < 2; ++i) { const int e = tid + 512 * i; vr[i] = *(const u32x4*)(proj + 2 * KIND_STRIDE + (hbase + 64 * (c) + (e >> 4)) * 128 + 8 * (e & 15)); } } while (0)
#define HG_GATE(c) do { const size_t row = hbase + 64 * (c) + 32 * tb + r; \
        _Pragma("unroll") for (int g = 0; g < 4; ++g) gwr[g] = *(const u32x2*)(proj + 3 * KIND_STRIDE + row * 128 + 32 * dvb + 8 * g + 4 * hh); } while (0)
#define HG_FINAL(c) do { float tot = (RP[(tb * 4 + 0) * 32 + r] + RP[(tb * 4 + 1) * 32 + r]) + (RP[(tb * 4 + 2) * 32 + r] + RP[(tb * 4 + 3) * 32 + r]); \
        const float rs = 1.0f / sqrtf(tot * (1.f / 128.f) + RMS_EPS); const size_t row = base + 64 * (c) + 32 * tb + r; \
        _Pragma("unroll") for (int g = 0; g < 4; ++g) { const int dv0 = h * 128 + 32 * dvb + 8 * g + 4 * hh; \
            const u32x2 gw = gwr[g]; const f32x4 g4 = *(const LAS f32x4*)(GNL + 32 * dvb + 8 * g + 4 * hh); \
            u32x2 ow; ow.x = cvt_pk_bf16(o[4 * g] * rs * g4[0] * bflo(gw.x), o[4 * g + 1] * rs * g4[1] * bfhi(gw.x)); \
            ow.y = cvt_pk_bf16(o[4 * g + 2] * rs * g4[2] * bflo(gw.y), o[4 * g + 3] * rs * g4[3] * bfhi(gw.y)); \
            *(u32x2*)(mix + row * DM + dv0) = ow; } } while (0)
    HG_LOAD_G(0); HG_LOAD(0);
#pragma unroll 1
    for (int c = 0; c < HG_CPS; ++c) {
        f32x2 gl[8]; gl[0] = gr[0];
#pragma unroll
        for (int i = 1; i < 8; ++i) gl[i] = gl[i - 1] + gr[i];
        *(LAS f32x2*)(GT + w * 128 + 2 * cp) = gl[7];
        if (c + 1 < HG_CPS) HG_LOAD_G(c + 1);
        LDS_BARRIER();
        if (MODE && c > 0) HG_FINAL(c - 1);
        f32x2 pre = (f32x2){0.f, 0.f}, ref = pre, tot2 = pre;
#pragma unroll
        for (int j = 0; j < 8; ++j) { const f32x2 t = *(const LAS f32x2*)(GT + j * 128 + 2 * cp); if (j < w) pre += t; if (j < 4) ref += t; tot2 += t; }
        dtot += tot2;
#pragma unroll
        for (int i = 0; i < 8; ++i) {
            const f32x2 G = pre + gl[i];
            const float k0 = bflo(kr[i]), k1 = bfhi(kr[i]);
            const float ek0 = __expf(fminf(ref[0] - G[0], 80.f)), ek1 = __expf(fminf(ref[1] - G[1], 80.f));
            const unsigned off = (8 * w + i) * HP + 4 * cp;
            *(LAS unsigned*)(KT + off) = cvt_pk_bf16(k0 * ek0, k1 * ek1);
            if (MODE) {
                const float q0 = bflo(qr[i]), q1 = bfhi(qr[i]);
                const float eq0 = __expf(fminf(G[0] - ref[0], 80.f)), eq1 = __expf(fminf(G[1] - ref[1], 80.f));
                const float eg0 = __expf(G[0]), eg1 = __expf(G[1]);
                *(LAS unsigned*)(QT + off) = cvt_pk_bf16(q0 * eq0, q1 * eq1);
                *(LAS unsigned*)(QG + off) = cvt_pk_bf16(q0 * eg0, q1 * eg1);
            }
        }
#pragma unroll
        for (int i = 0; i < 2; ++i) { const int e = tid + 512 * i; *(LAS u32x4*)(VV + (e >> 4) * HP + 16 * (e & 15)) = vr[i]; }
        if (w == 0) { *(LAS f32x2*)(EGL + 2 * cp) = (f32x2){__expf(tot2[0]), __expf(tot2[1])}; *(LAS f32x2*)(EGLR + 2 * cp) = (f32x2){__expf(tot2[0] - ref[0]), __expf(tot2[1] - ref[1])}; }
        if (MODE) {
#pragma unroll
            for (int g = 0; g < 4; ++g) {
                u32x2 a, b; a.x = cvt_pk_bf16(S0[4 * g], S0[4 * g + 1]); a.y = cvt_pk_bf16(S0[4 * g + 2], S0[4 * g + 3]); b.x = cvt_pk_bf16(S1[4 * g], S1[4 * g + 1]); b.y = cvt_pk_bf16(S1[4 * g + 2], S1[4 * g + 3]);
                const unsigned off = (32 * dvb + r) * HP + (64 * tb + 8 * g + 4 * hh) * 2;
                *(LAS u32x2*)(SP + off) = a; *(LAS u32x2*)(SP + off + 64) = b;
            }
            HG_GATE(c);
        }
        if (c + 1 < HG_CPS) HG_LOAD(c + 1);
        LDS_BARRIER();
        const unsigned vbase = (unsigned)(size_t)VV + 64 * dvb + trc, kbase = (unsigned)(size_t)KT + trc;
        if (MODE) {
            bf16x8 pf[2][2], qtf[8];
#pragma unroll
            for (int ks = 0; ks < 8; ++ks) qtf[ks] = *(const LAS bf16x8*)(QT + (32 * tb + r) * HP + 32 * ks + 16 * hh);
#pragma unroll
            for (int sb = 0; sb < 2; ++sb) if (sb <= tb) {
                f32x16 aT;
#pragma unroll
                for (int i = 0; i < 16; ++i) aT[i] = 0.f;
                { bf16x8 af[8];
#pragma unroll
                  for (int ks = 0; ks < 8; ++ks) af[ks] = *(const LAS bf16x8*)(KT + (32 * sb + r) * HP + 32 * ks + 16 * hh);
                  asm volatile("" ::: "memory");
#pragma unroll
                  for (int ks = 0; ks < 8; ++ks) aT = MFMA32(af[ks], qtf[ks], aT); }
                if (sb == tb) {
#pragma unroll
                    for (int i = 0; i < 16; ++i) aT[i] = (crow(i, hh) > r) ? 0.f : aT[i];
                }
                pf[sb][0] = pack8(aT[0], aT[1], aT[2], aT[3], aT[4], aT[5], aT[6], aT[7]);
                pf[sb][1] = pack8(aT[8], aT[9], aT[10], aT[11], aT[12], aT[13], aT[14], aT[15]);
            }
#pragma unroll
            for (int i = 0; i < 16; ++i) o[i] = 0.f;
            { bf16x8 af[8], bfr[8];
#pragma unroll
              for (int ks = 0; ks < 8; ++ks) { af[ks] = *(const LAS bf16x8*)(SP + (32 * dvb + r) * HP + 32 * ks + 16 * hh); bfr[ks] = *(const LAS bf16x8*)(QG + (32 * tb + r) * HP + 32 * ks + 16 * hh); }
              asm volatile("" ::: "memory");
#pragma unroll
              for (int ks = 0; ks < 8; ++ks) o = MFMA32(af[ks], bfr[ks], o); }
            { u32x2 vt[8]; tr_read8_perm(vbase + (4 * hh + q4) * HP, vt); tr_wait8(vt);
              o = MFMA32(as_bf16x8(vt[0], vt[1]), pf[0][0], o); o = MFMA32(as_bf16x8(vt[2], vt[3]), pf[0][1], o);
              if (tb) { o = MFMA32(as_bf16x8(vt[4], vt[5]), pf[1][0], o); o = MFMA32(as_bf16x8(vt[6], vt[7]), pf[1][1], o); } }
            float ss = 0.f;
#pragma unroll
            for (int i = 0; i < 16; ++i) ss += o[i] * o[i];
            ss += __shfl_xor(ss, 32);
            if (hh == 0) RP[(tb * 4 + dvb) * 32 + r] = ss;
        }
        if (MODE == 0 || c + 1 < HG_CPS) {
            u32x2 vf[8], kf[8];
            tr_read8_nat(vbase + (8 * hh + q4) * HP, vf);
            tr_read8_nat(kbase + 128 * tb + (8 * hh + q4) * HP, kf);
            tr_wait16(vf, kf);
#pragma unroll
            for (int j = 0; j < 2; ++j) {
                const int kkb = 2 * tb + j;
                f32x16 M;
#pragma unroll
                for (int i = 0; i < 16; ++i) M[i] = 0.f;
                if (j == 1) { tr_read8_nat(kbase + 128 * tb + 64 + (8 * hh + q4) * HP, kf); tr_wait8(kf); }
#pragma unroll
                for (int ks = 0; ks < 4; ++ks) M = MFMA32(as_bf16x8(kf[2 * ks], kf[2 * ks + 1]), as_bf16x8(vf[2 * ks], vf[2 * ks + 1]), M);
#pragma unroll
                for (int g = 0; g < 4; ++g) { const f32x4 el = *(const LAS f32x4*)(EGL + 32 * kkb + 8 * g + 4 * hh), er = *(const LAS f32x4*)(EGLR + 32 * kkb + 8 * g + 4 * hh);
#pragma unroll
                    for (int e = 0; e < 4; ++e) { if (j == 0) S0[4 * g + e] = el[e] * S0[4 * g + e] + er[e] * M[4 * g + e]; else S1[4 * g + e] = el[e] * S1[4 * g + e] + er[e] * M[4 * g + e]; } }
            }
        }
    }
    __syncthreads();
    if (MODE) { HG_FINAL(HG_CPS - 1); }
    else {
#pragma unroll
        for (int i = 0; i < 16; ++i) { sptr[i * 64] = S0[i]; sptr[1024 + i * 64] = S1[i]; }
        if (w == 0) *(f32x2*)(segd + (size_t)(bh * HG_NSEG + seg) * 128 + 2 * cp) = (f32x2){__expf(dtot[0]), __expf(dtot[1])};
    }
    __syncthreads();
#undef HG_LOAD
#undef HG_LOAD_G
#undef HG_GATE
#undef HG_FINAL
}
__device__ __forceinline__ void hgrn_seg_state(LAS unsigned char* lds, const bf16_t* proj, const float* logf, float* segs, float* segd, int bh, int seg) {
    const int tid = threadIdx.x, lane = tid & 63, w = tid >> 6, hh = lane >> 5, cp = lane;
    const int bb = bh / 6, h = bh % 6;
    constexpr size_t KIND_STRIDE = (size_t)6 * T_TOK * 128; const size_t hbase = (size_t)h * T_TOK + (size_t)bb * SEQ + (size_t)seg * 256;
    LAS unsigned char* KD = lds; LAS unsigned char* VV = lds + 69632; LAS float* GT2 = (LAS float*)(lds + 139264);
    const int tb = w >> 2, dvb = w & 3;
    const int i16 = lane & 15, q4 = i16 >> 2, p4 = i16 & 3, blk = (lane >> 4) & 1;
    const unsigned trc = 32 * blk + 8 * p4;
    { u32x4 vr[8];
#pragma unroll
      for (int i = 0; i < 8; ++i) { const int e = tid + 512 * i; vr[i] = *(const u32x4*)(proj + 2 * KIND_STRIDE + (hbase + (e >> 4)) * 128 + 8 * (e & 15)); }
#pragma unroll
      for (int i = 0; i < 8; ++i) { const int e = tid + 512 * i; *(LAS u32x4*)(VV + (e >> 4) * HP + 16 * (e & 15)) = vr[i]; } }
    f32x2 gl[32]; unsigned kr[32];
    { const size_t row0 = hbase + 32 * w;
#pragma unroll
      for (int i = 0; i < 32; ++i) { gl[i] = *(const f32x2*)(logf + (row0 + i) * 128 + 2 * cp); kr[i] = *(const unsigned*)(proj + KIND_STRIDE + (row0 + i) * 128 + 2 * cp); } }
#pragma unroll
    for (int i = 1; i < 32; ++i) gl[i] = gl[i - 1] + gl[i];
    *(LAS f32x2*)(GT2 + w * 128 + 2 * cp) = gl[31];
    __syncthreads();
    f32x2 pre = (f32x2){0.f, 0.f}, tot = pre;
#pragma unroll
    for (int j = 0; j < 8; ++j) { const f32x2 t = *(const LAS f32x2*)(GT2 + j * 128 + 2 * cp); if (j < w) pre += t; tot += t; }
    const f32x2 rem = tot - pre;
#pragma unroll
    for (int i = 0; i < 32; ++i) {
        const f32x2 d = rem - gl[i];
        const float e0 = __expf(fminf(d[0], 0.f)), e1 = __expf(fminf(d[1], 0.f));
        *(LAS unsigned*)(KD + (32 * w + i) * HP + 4 * cp) = cvt_pk_bf16(bflo(kr[i]) * e0, bfhi(kr[i]) * e1);
    }
    if (w == 0) *(f32x2*)(segd + (size_t)(bh * HG_NSEG + seg) * 128 + 2 * cp) = (f32x2){__expf(tot[0]), __expf(tot[1])};
    __syncthreads();
    f32x16 S0, S1;
#pragma unroll
    for (int i = 0; i < 16; ++i) { S0[i] = 0.f; S1[i] = 0.f; }
    const unsigned vbase = (unsigned)(size_t)VV + 64 * dvb + trc + (8 * hh + q4) * HP, kbase = (unsigned)(size_t)KD + trc + 128 * tb + (8 * hh + q4) * HP;
#pragma unroll 1
    for (int q = 0; q < 4; ++q) {
        u32x2 vf[8], kf0[8], kf1[8];
        tr_read8_nat(vbase + q * 64 * HP, vf); tr_read8_nat(kbase + q * 64 * HP, kf0); tr_read8_nat(kbase + q * 64 * HP + 64, kf1);
        tr_wait16(vf, kf0); tr_wait8(kf1);
#pragma unroll
        for (int ks = 0; ks < 4; ++ks) { S0 = MFMA32(as_bf16x8(kf0[2 * ks], kf0[2 * ks + 1]), as_bf16x8(vf[2 * ks], vf[2 * ks + 1]), S0);
                                         S1 = MFMA32(as_bf16x8(kf1[2 * ks], kf1[2 * ks + 1]), as_bf16x8(vf[2 * ks], vf[2 * ks + 1]), S1); }
    }
    float* sptr = segs + ((size_t)(bh * HG_NSEG + seg) * 16384) + (size_t)(w * 2) * 1024 + lane;
#pragma unroll
    for (int i = 0; i < 16; ++i) { sptr[i * 64] = S0[i]; sptr[1024 + i * 64] = S1[i]; }
    __syncthreads();
}

__device__ __forceinline__ void hgrn_scan(float* segs, const float* segd, int gtid, int nthr) {
    for (int e = gtid; e < 48 * 16384; e += nthr) {
        const int bh = e >> 14, idx = e & 16383, wj = idx >> 10, i = (idx >> 6) & 15, ln = idx & 63;
        const int kk = 32 * (2 * (wj >> 3) + (wj & 1)) + crow(i, ln >> 5);
        float sacc = 0.f;
#pragma unroll 4
        for (int sg = 0; sg < HG_NSEG; ++sg) {
            float* p = segs + (size_t)(bh * HG_NSEG + sg) * 16384 + idx;
            const float L = (sg < HG_NSEG - 1) ? *p : 0.f, d = (sg < HG_NSEG - 1) ? segd[(bh * HG_NSEG + sg) * 128 + kk] : 0.f;
            *p = sacc; sacc = d * sacc + L;
        }
    }
}

#define XB_TMO      128
#define XB_XCNT(j)  (256  + 64 * (j))
#define XB_XSUB(j)  (1280 + 64 * (j))
#define XB_XGEN(j)  (2304 + 64 * (j))
#define XB_TOP      3328
#define XB_TOPGEN   3392
#define XCD_BAR_WORDS 3456
#define XB_SPIN_CAP (1u << 18)
__device__ __forceinline__ unsigned xb_ld(unsigned* p)              { return __hip_atomic_load(p, __ATOMIC_RELAXED, __HIP_MEMORY_SCOPE_AGENT); }
__device__ __forceinline__ unsigned xb_add(unsigned* p, unsigned v) { return __hip_atomic_fetch_add(p, v, __ATOMIC_RELAXED, __HIP_MEMORY_SCOPE_AGENT); }
__device__ __forceinline__ unsigned xb_xcc_id() { return (unsigned)__builtin_amdgcn_s_getreg((3 << 11) | 20) & 0xFu; }
#define XB_SPIN(cond, bar) do { unsigned _sp = 0; while (cond) { __builtin_amdgcn_s_sleep(1); \
    if ((++_sp & 255u) == 0u) { if (xb_ld(&(bar)[XB_TMO])) break; if (_sp > XB_SPIN_CAP) { atomicAdd(&(bar)[XB_TMO], 1u); break; } } } } while (0)
struct XcdBarrier { unsigned* bar; unsigned x; volatile LAS unsigned* st; };
__device__ __forceinline__ XcdBarrier xcd_barrier_post(unsigned* bar, volatile LAS unsigned* st) {
    XcdBarrier b; b.bar = bar; b.x = xb_xcc_id(); b.st = st;
    if (threadIdx.x == 0) (void)xb_add(&bar[XB_XCNT(b.x)], 1u);
    return b;
}
__device__ __forceinline__ void xcd_barrier_complete(unsigned* bar, unsigned x, unsigned& nloc, unsigned& nx) {
    const unsigned G = gridDim.x * gridDim.y * gridDim.z;
    unsigned sum, cnt, mine, sp = 0u;
    for (;;) {
        sum = 0u; cnt = 0u; mine = 0u;
#pragma unroll
        for (unsigned j = 0; j < 16; ++j) { const unsigned c = xb_ld(&bar[XB_XCNT(j)]); sum += c; cnt += (c > 0u) ? 1u : 0u; mine = (j == x) ? c : mine; }
        if (sum == G) break;
        __builtin_amdgcn_s_sleep(1);
        if ((++sp & 255u) == 0u) { if (xb_ld(&bar[XB_TMO])) break; if (sp > XB_SPIN_CAP) { atomicAdd(&bar[XB_TMO], 1u); break; } }
    }
    nloc = mine > 0u ? mine : 1u; nx = cnt > 0u ? cnt : 1u;
}
__device__ __forceinline__ void xcd_barrier(const XcdBarrier& b) {
    asm volatile("s_waitcnt vmcnt(0)" ::: "memory");
    __syncthreads();
    if (threadIdx.x == 0) {
        unsigned* bar = b.bar;
        __builtin_amdgcn_s_waitcnt(0);
        unsigned nloc = b.st[0], nx = b.st[1];
        if (nloc == 0u) { xcd_barrier_complete(bar, b.x, nloc, nx); b.st[0] = nloc; b.st[1] = nx; }
        const unsigned old = xb_add(&bar[XB_XSUB(b.x)], 1u);
        const unsigned gen = old / nloc;
        if (old + 1u == (gen + 1u) * nloc) {
            __builtin_amdgcn_fence(__ATOMIC_RELEASE, "agent");
            asm volatile("s_waitcnt vmcnt(0)" ::: "memory");
            const unsigned og = xb_add(&bar[XB_TOP], 1u);
            const unsigned tg = og / nx;
            if (og + 1u == (tg + 1u) * nx) xb_add(&bar[XB_TOPGEN], 1u);
            else XB_SPIN(xb_ld(&bar[XB_TOPGEN]) == tg, bar);
            __builtin_amdgcn_fence(__ATOMIC_ACQUIRE, "agent");
            xb_add(&bar[XB_XGEN(b.x)], 1u);
            asm volatile("s_waitcnt vmcnt(0)" ::: "memory");
        } else {
            XB_SPIN(xb_ld(&bar[XB_XGEN(b.x)]) == gen, bar);
            __builtin_amdgcn_fence(__ATOMIC_ACQUIRE, "agent");
            asm volatile("s_waitcnt vmcnt(0)" ::: "memory");
        }
    }
    __syncthreads();
}
constexpr size_t OFF_BAR = 98304;

__global__ void __launch_bounds__(512, 2) fwd_kernel(Args args) {
    extern __shared__ __attribute__((aligned(16))) unsigned char lds_raw[];
    LAS unsigned char* lds = (LAS unsigned char*)lds_raw;
    cg::grid_group grid = cg::this_grid();
    const int tid = threadIdx.x, lane = tid & 63, wave = __builtin_amdgcn_readfirstlane(tid >> 6);
    const int G = gridDim.x, bx = blockIdx.x;
    unsigned char* ws = args.ws;
    const float* x = args.in[0]; const float* mem = args.in[1]; const float* w_in_sb = args.in[2]; const float* w_in_hg = args.in[3]; const float* w_mem_kv = args.in[4];
    const float* lower_bounds = args.in[5]; const float* hg_norm_g = args.in[6]; const float* w_out = args.in[7]; const float* ln_mix_g = args.in[8]; const float* ln_mix_b = args.in[9];
    const float* w_up = args.in[10]; const float* w_down = args.in[11]; const float* ln_ffn_g = args.in[12]; const float* ln_ffn_b = args.in[13];
    float* out = args.out;
    bf16_t* WSB = (bf16_t*)(ws + WS_WSB); bf16_t* WHG = (bf16_t*)(ws + WS_WHG); bf16_t* WKV = (bf16_t*)(ws + WS_WKV); bf16_t* WOUT = (bf16_t*)(ws + WS_WOUT);
    bf16_t* WUP = (bf16_t*)(ws + WS_WUP); bf16_t* WDN = (bf16_t*)(ws + WS_WDN); bf16_t* MEMB = (bf16_t*)(ws + WS_MEMB); bf16_t* MEMKV = (bf16_t*)(ws + WS_MEMKV);
    float* ST1 = (float*)(ws + OFF_ST1); float* ST2 = (float*)(ws + OFF_ST2); float* ST3 = (float*)(ws + OFF_ST3);
    bf16_t* UB = (bf16_t*)(ws + WS_UB); bf16_t* MIX = (bf16_t*)(ws + WS_MIX); bf16_t* PROJ = (bf16_t*)(ws + WS_PROJ); float* LOGF = (float*)(ws + WS_LOGF); bf16_t* HB = (bf16_t*)(ws + WS_H);
    float* C1HG = (float*)(ws + OFF_C1HG); float* C2HG = (float*)(ws + OFF_C2HG); float* C1UP0 = (float*)(ws + OFF_C1UP0); float* C2UP0 = (float*)(ws + OFF_C2UP0);
    float* C1UP1 = (float*)(ws + OFF_C1UP1); float* C2UP1 = (float*)(ws + OFF_C2UP1);
    const int lo = args.ph_lo, hi = args.ph_hi;
    volatile LAS unsigned* bst = (volatile LAS unsigned*)(lds + 147392);
    if (tid < 2) bst[tid] = 0u;
    __syncthreads();
    const XcdBarrier gbar = xcd_barrier_post((unsigned*)(ws + OFF_BAR), bst);
    if (lo < 0) grid.sync();
#define GRID_SYNC() xcd_barrier(gbar)
#define IN(k) (lo <= (k) && (k) < hi)
#define SEAM(k) do { if (IN(k) && IN((k) + 1)) GRID_SYNC(); } while (0)
    const int gtid = bx * 512 + tid, nthr = G * 512;

    if (IN(0)) {
        LAS float* scr = (LAS float*)(lds + wave * 16384);
        const int gw = bx * 8 + wave, NGW = G * 8;
        constexpr int I_SB = 16 * (NP0 / 32), I_HG = 16 * (NP1 / 32), I_KV = 16 * (512 / 32), I_OUT = 16 * (1024 / 32), I_UP = 16 * (4096 / 32), I_DN = 64 * (1024 / 32);
                constexpr int N_EARLY = I_SB + 2 * I_KV;
        for (int it = gw; it < N_EARLY; it += NGW) {
            int r = it;
            if (r < I_SB) { p0_transpose_item(w_in_sb, 1024, NP0, WSB, scr, r, lane, nullptr, nullptr, nullptr, nullptr); continue; } r -= I_SB;
            if (r < I_KV) { p0_transpose_item(w_mem_kv, 1024, 512, WKV, scr, r, lane, nullptr, nullptr, nullptr, nullptr); continue; } r -= I_KV;
            p0_transpose_item(w_mem_kv + 1024 * 512, 1024, 512, WKV + 512 * 1024, scr, r, lane, nullptr, nullptr, nullptr, nullptr);
        }
        for (int m = gw; m < T_TOK; m += NGW) row_to_bf16(x + (size_t)m * DM, UB + (size_t)m * DM, lane);
        for (int m = gw; m < 2048; m += NGW) row_to_bf16(mem + (size_t)m * DM, MEMB + (size_t)m * DM, lane);
        __syncthreads();
    }
    SEAM(0);
    if (IN(1)) {
        { pg8::Gemm g{UB, WSB, T_TOK, NP0, 1024}; pg8::StaticOrder S; S.init(T_TOK, NP0, G, bx); EpiBf16Plain E{PROJ, NP0, 0x207u, (0.125f * 1.44269504f)}; pg8::gemm_phase(lds, g, S, E); }
        if (bx < 32 || G <= 64) { pg8::Gemm g{MEMB, WKV, 2048, 1024, 1024}; pg8::StaticOrder S; S.init(2048, 1024, G, bx); EpiBf16Plain E{MEMKV, 1024, 0u, 1.0f}; pg8::gemm_phase(lds, g, S, E); }
        if (bx >= 32 || G <= 64) {
            LAS float* scr = (LAS float*)(lds + wave * 16384);
            const int nb0 = (G <= 64) ? 0 : 32, gw = (bx - nb0) * 8 + wave, NGW = (G - nb0) * 8;
            constexpr int I_HG = 16 * (NP1 / 32), I_OUT = 16 * (1024 / 32), I_UP = 16 * (4096 / 32), I_DN = 64 * (1024 / 32);
            constexpr int N_LATE = I_HG + 2 * I_OUT + 2 * I_UP + 2 * I_DN;
            for (int it = gw; it < N_LATE; it += NGW) {
                int r = it;
                if (r < I_HG) { p0_transpose_item(w_in_hg, 1024, NP1, WHG, scr, r, lane, ln_ffn_g, ln_ffn_b, C1HG, C2HG); continue; } r -= I_HG;
                if (r < I_OUT) { p0_transpose_item(w_out, 1024, 1024, WOUT, scr, r, lane, nullptr, nullptr, nullptr, nullptr); continue; } r -= I_OUT;
                if (r < I_OUT) { p0_transpose_item(w_out + 1024 * 1024, 1024, 1024, WOUT + 1024 * 1024, scr, r, lane, nullptr, nullptr, nullptr, nullptr); continue; } r -= I_OUT;
                if (r < I_UP) { p0_transpose_item(w_up, 1024, 4096, WUP, scr, r, lane, ln_mix_g, ln_mix_b, C1UP0, C2UP0); continue; } r -= I_UP;
                if (r < I_UP) { p0_transpose_item(w_up + 1024 * 4096, 1024, 4096, WUP + 4096 * 1024, scr, r, lane, ln_mix_g + 1024, ln_mix_b + 1024, C1UP1, C2UP1); continue; } r -= I_UP;
                if (r < I_DN) { p0_transpose_item(w_down, 4096, 1024, WDN, scr, r, lane, nullptr, nullptr, nullptr, nullptr); continue; } r -= I_DN;
                p0_transpose_item(w_down + 4096 * 1024, 4096, 1024, WDN + 1024 * 4096, scr, r, lane, nullptr, nullptr, nullptr, nullptr);
            }
            __syncthreads();
        }
    }
    SEAM(1);
    if (IN(2)) {
        for (int u = bx; u < 8 * 6 * 32; u += G) sb_attn_unit2(lds, PROJ, MIX, u);
        for (int u = bx; u < 512; u += G) mem_attn_unit(lds, PROJ, NP0, 2304, MEMKV, MIX, u);
    }
    SEAM(2);
    if (IN(3)) { pg8::Gemm g{MIX, WOUT, T_TOK, 1024, 1024}; pg8::StaticOrder S; S.init(T_TOK, 1024, G, bx);
        EpiResid<0, 1> E{x, UB, nullptr, ST1, nullptr, nullptr}; pg8::gemm_phase(lds, g, S, E); }
    SEAM(3);
    if (IN(4)) { pg8::Gemm g{UB, WUP, T_TOK, 4096, 1024}; pg8::StaticOrder S; S.init(T_TOK, 4096, G, bx);
        EpiUp E{HB, ST1, C1UP0, C2UP0}; pg8::gemm_phase(lds, g, S, E); }
    SEAM(4);
    if (IN(5)) { pg8::Gemm g{HB, WDN, T_TOK, 1024, 4096}; pg8::StaticOrder S; S.init(T_TOK, 1024, G, bx);
        EpiResid<1, 1> E{nullptr, UB, ST1, ST2, ln_mix_g, ln_mix_b}; pg8::gemm_phase(lds, g, S, E); }
    SEAM(5);
    if (IN(6)) { pg8::Gemm g{UB, WHG, T_TOK, NP1, 1024}; pg8::StaticOrder S; S.init(T_TOK, NP1, G, bx);
        EpiProj1 E{PROJ, LOGF, ST2, C1HG, C2HG, lower_bounds}; pg8::gemm_phase(lds, g, S, E); }
    SEAM(6);
    if (IN(7)) {
        float* SEGS = out; float* SEGD = out + (size_t)768 * 16384;
        for (int u = bx; u < 720 + 512; u += G) {
            if (u < 720) hgrn_seg_state(lds, PROJ, LOGF, SEGS, SEGD, u / 15, u % 15);
            else mem_attn_unit(lds, PROJ + (size_t)4 * 6 * T_TOK * 128, 256, 0, MEMKV + 512, MIX, u - 720);
        }
        GRID_SYNC();
        hgrn_scan(SEGS, SEGD, gtid, nthr);
        GRID_SYNC();
        for (int u = bx; u < 768; u += G) hgrn_seg<1>(lds, PROJ, LOGF, hg_norm_g, MIX, SEGS, SEGD, u >> 4, u & 15);
    }
    SEAM(7);
    if (IN(8)) { pg8::Gemm g{MIX, WOUT + 1024 * 1024, T_TOK, 1024, 1024}; pg8::StaticOrder S; S.init(T_TOK, 1024, G, bx);
        EpiResid<1, 1> E{nullptr, UB, ST2, ST3, ln_ffn_g, ln_ffn_b}; pg8::gemm_phase(lds, g, S, E); }
    SEAM(8);
    if (IN(9)) { pg8::Gemm g{UB, WUP + 4096 * 1024, T_TOK, 4096, 1024}; pg8::StaticOrder S; S.init(T_TOK, 4096, G, bx);
        EpiUp E{HB, ST3, C1UP1, C2UP1}; pg8::gemm_phase(lds, g, S, E); }
    SEAM(9);
    if (IN(10)) { pg8::Gemm g{HB, WDN + 1024 * 4096, T_TOK, 1024, 4096}; pg8::StaticOrder S; S.init(T_TOK, 1024, G, bx);
        EpiResid<1, 0> E{nullptr, UB, ST3, nullptr, ln_mix_g + 1024, ln_mix_b + 1024}; pg8::gemm_phase(lds, g, S, E); }
    SEAM(10);
    if (IN(11)) {
        const int gw = bx * 8 + wave, NGW = G * 8;
        const float* gg = ln_ffn_g + 1024; const float* bb = ln_ffn_b + 1024;
        for (int m = gw; m < T_TOK; m += NGW) {
            const u32x4* ur = (const u32x4*)(UB + (size_t)m * DM) + lane;
            f32x4 v[4]; float s = 0.f;
#pragma unroll
            for (int j = 0; j < 2; ++j) { const u32x4 wv = ur[64 * j];
                v[2 * j] = (f32x4){bflo(wv.x), bfhi(wv.x), bflo(wv.y), bfhi(wv.y)}; v[2 * j + 1] = (f32x4){bflo(wv.z), bfhi(wv.z), bflo(wv.w), bfhi(wv.w)}; }
#pragma unroll
            for (int j = 0; j < 4; ++j) s += (v[j][0] + v[j][1]) + (v[j][2] + v[j][3]);
            const float mean = wave_sum(s) * (1.f / DM); float s2 = 0.f;
#pragma unroll
            for (int j = 0; j < 4; ++j) { v[j] = v[j] - mean; s2 += (v[j][0] * v[j][0] + v[j][1] * v[j][1]) + (v[j][2] * v[j][2] + v[j][3] * v[j][3]); }
            const float rstd = 1.f / sqrtf(wave_sum(s2) * (1.f / DM) + LN_EPS);
#pragma unroll
            for (int j = 0; j < 4; ++j) { const int col = 512 * (j >> 1) + 8 * lane + 4 * (j & 1);
                const f32x4 g4 = *(const f32x4*)(gg + col), b4 = *(const f32x4*)(bb + col); *(f32x4*)(out + (size_t)m * DM + col) = v[j] * rstd * g4 + b4; }
        }
    }
#undef IN
#undef SEAM
}

constexpr int N_PHASES = 12;
extern "C" void kernel_launch(void* const* d_in, const int* in_sizes, int n_in, void* d_out, int out_size, void* d_ws, size_t ws_size, hipStream_t stream) {
    static int grid = 0;
    if (grid == 0) {
        if (n_in != 14 || in_sizes[0] != T_TOK * DM || out_size != T_TOK * DM || ws_size < WS_END) { fprintf(stderr, "kernel_launch: unexpected shapes (n_in %d, ws %zu)\n", n_in, ws_size); grid = -1; return; }
        int dev = 0, cus = 0, per_cu = 0;
        hipGetDevice(&dev); hipDeviceGetAttribute(&cus, hipDeviceAttributeMultiprocessorCount, dev);
        if (hipFuncSetAttribute((const void*)fwd_kernel, hipFuncAttributeMaxDynamicSharedMemorySize, LDS_BYTES) != hipSuccess) { fprintf(stderr, "kernel_launch: hipFuncSetAttribute failed\n"); grid = -1; return; }
        if (hipOccupancyMaxActiveBlocksPerMultiprocessor(&per_cu, (const void*)fwd_kernel, 512, LDS_BYTES) != hipSuccess || per_cu < 1) { fprintf(stderr, "kernel_launch: occupancy query says %d\n", per_cu); per_cu = 1; }
        (void)hipGetLastError();
        grid = cus * 1;
    }
    if (grid < 0) return;
    hipMemsetAsync((char*)d_ws + WS_CTL, 0, CTL_ZERO_BYTES, stream);
    Args a{};
    for (int i = 0; i < 14; ++i) a.in[i] = (const float*)d_in[i];
    a.out = (float*)d_out; a.ws = (unsigned char*)d_ws;
    a.ph_lo = 0; a.ph_hi = N_PHASES;
    void* kargs[] = {&a};
    hipError_t e = hipLaunchCooperativeKernel((const void*)fwd_kernel, dim3(grid), dim3(512), kargs, LDS_BYTES, stream);
    if (e != hipSuccess) fprintf(stderr, "cooperative launch failed: %s (grid %d)\n", hipGetErrorString(e), grid);
}
```

```cpp
#include <hip/hip_runtime.h>
#include <hip/hip_cooperative_groups.h>
#include <cstdio>
namespace cg = cooperative_groups;

#define LAS __attribute__((address_space(3)))
typedef unsigned short bf16_t;
typedef short bf16x8 __attribute__((ext_vector_type(8)));
typedef float f32x4 __attribute__((ext_vector_type(4)));
typedef float f32x2 __attribute__((ext_vector_type(2)));
typedef unsigned u32x4 __attribute__((ext_vector_type(4)));
typedef unsigned u32x2 __attribute__((ext_vector_type(2)));

constexpr int T_TOK = 32768, SEQ = 4096, DM = 1024, DFF = 4096;
constexpr int NP0 = 2560, NP1 = 3328;
constexpr float ALPHA = 1.41421356237f, LN_EPS = 1e-5f, RMS_EPS = 1e-6f;

constexpr size_t MiB = 1u << 20;
constexpr size_t WS_CTL = 0, CTL_ZERO_BYTES = 1024 * 1024;
constexpr size_t OFF_ST1 = 131072, OFF_ST2 = 131072 + 262144, OFF_ST3 = 131072 + 2 * 262144;
constexpr size_t OFF_C1HG = 0, OFF_C2HG = 16384, OFF_C1UP0 = 32768, OFF_C2UP0 = 49152, OFF_C1UP1 = 65536, OFF_C2UP1 = 81920;
constexpr size_t WS_WSB = 1 * MiB, WS_WHG = 6 * MiB, WS_WKV = 13 * MiB, WS_WOUT = 15 * MiB, WS_WUP = 19 * MiB, WS_WDN = 35 * MiB;
constexpr size_t WS_MEMB = 51 * MiB, WS_MEMKV = 55 * MiB;
constexpr size_t WS_UB = 68 * MiB, WS_MIX = 132 * MiB, WS_PROJ = 196 * MiB, WS_LOGF = 404 * MiB, WS_H = 196 * MiB, WS_END = 500 * MiB;
static_assert(WS_PROJ + (size_t)T_TOK * NP1 * 2 <= WS_LOGF, "proj");
static_assert(WS_LOGF + (size_t)T_TOK * 768 * 4 <= WS_END, "logf");
static_assert(WS_H + (size_t)T_TOK * DFF * 2 <= WS_END, "h");

constexpr int LDS_BYTES = 147456;

__device__ __forceinline__ unsigned cvt_pk_bf16(float lo, float hi) { unsigned r; asm volatile("v_cvt_pk_bf16_f32 %0, %1, %2" : "=v"(r) : "v"(lo), "v"(hi)); return r; }
__device__ __forceinline__ float bf2f(bf16_t b) { return __uint_as_float(((unsigned)b) << 16); }
__device__ __forceinline__ float bflo(unsigned w) { return __uint_as_float(w << 16); }
__device__ __forceinline__ float bfhi(unsigned w) { return __uint_as_float(w & 0xffff0000u); }
__device__ __forceinline__ bf16_t f2bf(float f) { return (bf16_t)(cvt_pk_bf16(f, 0.f) & 0xffffu); }
__device__ __forceinline__ float wave_sum(float v) {
#pragma unroll
    for (int o = 1; o < 64; o <<= 1) v += __shfl_xor(v, o);
    return v;
}

namespace pg8 {
constexpr int BM = 256, BK = 64, HALF = 128, HTB = HALF * BK * 2, STAGE_BYTES = 8 * HTB, NXCD = 8, WGM = 4;
__host__ __device__ __forceinline__ int lds_byte(int r, int c) { const int st = (r >> 4) * 2 + (c >> 5), rr = r & 15, cc = c & 31, ob = rr * 64 + cc * 2; return st * 1024 + (ob ^ (((ob >> 9) & 1) << 5)); }
__host__ __device__ __forceinline__ void stage_rc(int b, int& R, int& C) { const int st = b / 1024, sb = b % 1024, swz = sb ^ (((sb >> 9) & 1) << 5); R = (st >> 1) * 16 + swz / 64; C = (st & 1) * 32 + (swz % 64) / 2; }
__host__ __device__ __forceinline__ int perm32(int rho) { const int n = rho >> 4, i = rho & 15; return 8 * (i >> 2) + 4 * n + (i & 3); }
struct Unit { int pm, pn; };
struct Gemm { const bf16_t* A; const bf16_t* Bt; int M, N, K; };
struct StaticOrder {
    int nM, nN, nwg, G, c;
    __host__ __device__ void init(int M, int N, int G_, int c_) { nM = M / BM; nN = N / BM; nwg = nM * nN; G = G_; c = c_; }
    __host__ __device__ bool next(int i, Unit& u) const {
        const long L = (long)i * G + c; if (L >= nwg) return false;
        int wgid = (int)L; { const int q = nwg / NXCD, r = nwg % NXCD, xcd = wgid % NXCD, off = wgid / NXCD; wgid = (xcd < r ? xcd * (q + 1) : r * (q + 1) + (xcd - r) * q) + off; }
        const int nig = WGM * nN, gid = wgid / nig, fm = gid * WGM, gsz = (nM - fm) < WGM ? (nM - fm) : WGM;
        u.pm = fm + ((wgid % nig) % gsz); u.pn = (wgid % nig) / gsz; return true;
    }
};

template <class Epi, class Sched, bool ALIGN_EPI = true, bool SP2 = true>
__device__ __forceinline__ void gemm_phase(LAS unsigned char* lds, const Gemm g, const Sched& S, const Epi& E) {
    const int tid = threadIdx.x, wid = __builtin_amdgcn_readfirstlane(tid >> 6), lane = tid & 63, wr = wid >> 2, wc = wid & 3, fr = lane & 15, fq = lane >> 4;
    const int K = g.K, nt = K / BK;
    unsigned voffA[2], voffB[2];
#pragma unroll
    for (int i = 0; i < 2; ++i) { int R, C; stage_rc(tid * 16 + i * 8192, R, C); const int Rb = Epi::PERM ? ((R & ~31) + perm32(R & 31)) : R;
        voffA[i] = (unsigned)(R * K + C) * 2u; voffB[i] = (unsigned)(Rb * K + C) * 2u; }
    const size_t kstep = (size_t)(BK * 2);
    const size_t hstep = (size_t)HALF * K * 2;
    const size_t tstep = 2 * hstep;
    const unsigned ldsw = (unsigned)wid * 1024u;
    const int aoff = lds_byte(wr * 64 + fr, fq * 8), boff = lds_byte(wc * 32 + fr, fq * 8);
#define PG8_SA(b, h) (((b) * 2 + (h)) * HTB)
#define PG8_SB(b, h) ((4 + (b) * 2 + (h)) * HTB)
#define PG8_STAGE(bufoff, gbase, voff) do { _Pragma("unroll") for (int _i = 0; _i < 2; ++_i) \
        __builtin_amdgcn_global_load_lds((const unsigned*)((const char*)(gbase) + (voff)[_i]), (LAS unsigned*)(lds + (bufoff) + ldsw + _i * 8192), 16, 0, 0); } while (0)
#define PG8_LDA(dst, b, h) do { _Pragma("unroll") for (int m = 0; m < 4; ++m) _Pragma("unroll") for (int k = 0; k < 2; ++k) dst[m][k] = *(const LAS bf16x8*)(lds + PG8_SA(b, h) + aoff + m * 2048 + k * 1024); } while (0)
#define PG8_LDB(dst, b, h) do { _Pragma("unroll") for (int n = 0; n < 2; ++n) _Pragma("unroll") for (int k = 0; k < 2; ++k) dst[n][k] = *(const LAS bf16x8*)(lds + PG8_SB(b, h) + boff + n * 2048 + k * 1024); } while (0)
#define PG8_MMA(ai, bj, At, Bt) do { __builtin_amdgcn_s_setprio(1); _Pragma("unroll") for (int m = 0; m < 4; ++m) _Pragma("unroll") for (int n = 0; n < 2; ++n) _Pragma("unroll") for (int k = 0; k < 2; ++k) \
        acc[ai][bj][m][n] = __builtin_amdgcn_mfma_f32_16x16x32_bf16(Bt[n][k], At[m][k], acc[ai][bj][m][n], 0, 0, 0); __builtin_amdgcn_s_setprio(0); } while (0)
#define PG8_WAIT_V(n) asm volatile("s_waitcnt vmcnt(" #n ")" ::: "memory")
#define PG8_WAIT_L(n) asm volatile("s_waitcnt lgkmcnt(" #n ")" ::: "memory")
#define PG8_BAR __builtin_amdgcn_s_barrier()
#define PG8_SCHED __builtin_amdgcn_sched_barrier(0)
    Unit cur, nxt; int ui = 0;
    if (!S.next(0, cur)) return;
    f32x4 acc[2][2][4][2];
#pragma unroll
    for (int a = 0; a < 2; ++a)
#pragma unroll
        for (int b = 0; b < 2; ++b)
#pragma unroll
            for (int m = 0; m < 4; ++m)
#pragma unroll
                for (int n = 0; n < 2; ++n) acc[a][b][m][n] = (f32x4){0.f, 0.f, 0.f, 0.f};
    bf16x8 At[4][2], B0[2][2], B1[2][2];
    const char* cA = (const char*)g.A + (size_t)cur.pm * tstep; const char* cB = (const char*)g.Bt + (size_t)cur.pn * tstep;
    if constexpr (SP2) {
        PG8_STAGE(PG8_SB(0, 0), cB, voffB); PG8_STAGE(PG8_SB(0, 1), cB + hstep, voffB); PG8_STAGE(PG8_SA(0, 0), cA, voffA); PG8_STAGE(PG8_SA(0, 1), cA + hstep, voffA);
        if (wr == 1) PG8_BAR;
        PG8_WAIT_V(2); PG8_BAR;
        PG8_STAGE(PG8_SB(1, 0), cB + kstep, voffB); PG8_STAGE(PG8_SA(1, 0), cA + kstep, voffA); PG8_STAGE(PG8_SB(1, 1), cB + hstep + kstep, voffB);
        PG8_WAIT_V(6); PG8_BAR;
    } else {
        PG8_STAGE(PG8_SB(0, 0), cB, voffB); PG8_STAGE(PG8_SA(0, 0), cA, voffA); PG8_STAGE(PG8_SB(0, 1), cB + hstep, voffB); PG8_STAGE(PG8_SA(0, 1), cA + hstep, voffA);
        if (wr == 1) PG8_BAR;
        PG8_WAIT_V(4); PG8_BAR;
        PG8_STAGE(PG8_SB(1, 0), cB + kstep, voffB); PG8_STAGE(PG8_SA(1, 0), cA + kstep, voffA); PG8_STAGE(PG8_SB(1, 1), cB + hstep + kstep, voffB);
        PG8_WAIT_V(6); PG8_BAR;
    }
    for (;;) {
        const bool has_next = S.next(ui + 1, nxt);
        const char* nA = has_next ? (const char*)g.A + (size_t)nxt.pm * tstep : cA; const char* nB = has_next ? (const char*)g.Bt + (size_t)nxt.pn * tstep : cB;
        for (int t = 0; t < nt; t += 2) {
            const bool last = (t == nt - 2);
            const char* a1 = cA + (size_t)(t + 1) * kstep;
            const char* a2 = last ? nA : cA + (size_t)(t + 2) * kstep; const char* b2 = last ? nB : cB + (size_t)(t + 2) * kstep;
            const char* a3 = a2 + kstep; const char* b3 = b2 + kstep;
            if constexpr (SP2) {
            PG8_LDB(B0, 0, 0); PG8_LDB(B1, 0, 1); PG8_SCHED; PG8_LDA(At, 0, 0); PG8_STAGE(PG8_SA(1, 1), a1 + hstep, voffA);
            PG8_WAIT_V(8); PG8_WAIT_L(0); PG8_BAR; PG8_MMA(0, 0, At, B0); PG8_MMA(0, 1, At, B1); PG8_BAR; PG8_SCHED;
            PG8_LDA(At, 0, 1); PG8_STAGE(PG8_SB(0, 0), b2, voffB); PG8_STAGE(PG8_SB(0, 1), b2 + hstep, voffB); PG8_STAGE(PG8_SA(0, 0), a2, voffA);
            PG8_WAIT_V(8); PG8_WAIT_L(0); PG8_BAR; PG8_MMA(1, 0, At, B0); PG8_MMA(1, 1, At, B1); PG8_BAR; PG8_SCHED;
            PG8_LDB(B0, 1, 0); PG8_LDB(B1, 1, 1); PG8_SCHED; PG8_LDA(At, 1, 0); PG8_STAGE(PG8_SA(0, 1), a2 + hstep, voffA);
            PG8_WAIT_V(8); PG8_WAIT_L(0); PG8_BAR; PG8_MMA(0, 0, At, B0); PG8_MMA(0, 1, At, B1); PG8_BAR; PG8_SCHED;
            PG8_LDA(At, 1, 1); PG8_STAGE(PG8_SB(1, 0), b3, voffB); PG8_STAGE(PG8_SB(1, 1), b3 + hstep, voffB); PG8_STAGE(PG8_SA(1, 0), a3, voffA);
            PG8_WAIT_V(8); PG8_WAIT_L(0); PG8_BAR; PG8_MMA(1, 0, At, B0); PG8_MMA(1, 1, At, B1); PG8_BAR; PG8_SCHED;
            } else {
            PG8_LDB(B0, 0, 0); PG8_SCHED; PG8_LDA(At, 0, 0); PG8_STAGE(PG8_SA(1, 1), a1 + hstep, voffA);
            PG8_WAIT_L(8); PG8_BAR; PG8_WAIT_L(0); PG8_MMA(0, 0, At, B0); PG8_BAR; PG8_SCHED;
            PG8_LDB(B1, 0, 1); PG8_STAGE(PG8_SB(0, 0), b2, voffB);
            PG8_BAR; PG8_WAIT_L(0); PG8_MMA(0, 1, At, B1); PG8_BAR;
            PG8_LDA(At, 0, 1); PG8_STAGE(PG8_SA(0, 0), a2, voffA);
            PG8_BAR; PG8_WAIT_L(0); PG8_MMA(1, 0, At, B0); PG8_BAR; PG8_SCHED;
            PG8_STAGE(PG8_SB(0, 1), b2 + hstep, voffB);
            PG8_WAIT_V(6); PG8_BAR; PG8_MMA(1, 1, At, B1); PG8_BAR;
            PG8_LDB(B0, 1, 0); PG8_SCHED; PG8_LDA(At, 1, 0); PG8_STAGE(PG8_SA(0, 1), a2 + hstep, voffA);
            PG8_WAIT_L(8); PG8_BAR; PG8_WAIT_L(0); PG8_MMA(0, 0, At, B0); PG8_BAR; PG8_SCHED;
            PG8_LDB(B1, 1, 1); PG8_STAGE(PG8_SB(1, 0), b3, voffB);
            PG8_BAR; PG8_WAIT_L(0); PG8_MMA(0, 1, At, B1); PG8_BAR;
            PG8_LDA(At, 1, 1); PG8_STAGE(PG8_SA(1, 0), a3, voffA);
            PG8_BAR; PG8_WAIT_L(0); PG8_MMA(1, 0, At, B0); PG8_BAR; PG8_SCHED;
            PG8_STAGE(PG8_SB(1, 1), b3 + hstep, voffB);
            PG8_WAIT_V(6); PG8_BAR; PG8_MMA(1, 1, At, B1); PG8_BAR;
            }
        }
        if constexpr (ALIGN_EPI) { if (wr == 0) PG8_BAR; }
        E(acc, cur, wr, wc, fr, fq);
        if (!has_next) break;
#pragma unroll
        for (int a = 0; a < 2; ++a)
#pragma unroll
            for (int b = 0; b < 2; ++b)
#pragma unroll
                for (int m = 0; m < 4; ++m)
#pragma unroll
                    for (int n = 0; n < 2; ++n) acc[a][b][m][n] = (f32x4){0.f, 0.f, 0.f, 0.f};
        cur = nxt; cA = nA; cB = nB; ++ui;
        if constexpr (ALIGN_EPI) { if (wr == 1) PG8_BAR; }
    }
    PG8_WAIT_V(0);
    if constexpr (!ALIGN_EPI) { if (wr == 0) PG8_BAR; }
    PG8_BAR;
#undef PG8_SA
#undef PG8_SB
#undef PG8_STAGE
#undef PG8_LDA
#undef PG8_LDB
#undef PG8_MMA
#undef PG8_WAIT_V
#undef PG8_WAIT_L
#undef PG8_BAR
#undef PG8_SCHED
}
}

typedef f32x4 AccT[2][2][4][2];

__device__ __forceinline__ void mean_rstd(const f32x2 sv, float& mean, float& rstd) {
    mean = sv[0] * (1.f / DM);
    rstd = 1.0f / sqrtf(fmaxf(sv[1] * (1.f / DM) - mean * mean, 0.f) + LN_EPS);
}
__device__ __forceinline__ void stat_add(float* st, int row, float s1, float s2) {
    (void)__hip_atomic_fetch_add(st + 2 * (size_t)row, s1, __ATOMIC_RELAXED, __HIP_MEMORY_SCOPE_AGENT);
    (void)__hip_atomic_fetch_add(st + 2 * (size_t)row + 1, s2, __ATOMIC_RELAXED, __HIP_MEMORY_SCOPE_AGENT);
}

#define AT(T, base, byteoff) (*(T*)((char*)(base) + (size_t)(unsigned)(byteoff)))
#define ATC(T, base, byteoff) (*(const T*)((const char*)(base) + (size_t)(unsigned)(byteoff)))

struct EpiBf16Plain {
    static constexpr bool PERM = true;
    bf16_t* O; int ldc; unsigned qmask; float qscale;
    __device__ __forceinline__ void operator()(const AccT& acc, const pg8::Unit& u, int wr, int wc, int fr, int fq) const {
        const int row0 = u.pm * 256 + wr * 64 + fr, col0 = u.pn * 256 + wc * 32 + 8 * fq;
        const float sc = ((qmask >> u.pn) & 1u) ? qscale : 1.0f;
        const unsigned rstride = (unsigned)ldc * 2u;
#pragma unroll
        for (int ai = 0; ai < 2; ++ai)
#pragma unroll
            for (int m = 0; m < 4; ++m) { const unsigned off = (unsigned)(row0 + ai * 128 + m * 16) * rstride + (unsigned)col0 * 2u;
#pragma unroll
                for (int bj = 0; bj < 2; ++bj) { const f32x4 v0 = acc[ai][bj][m][0] * sc, v1 = acc[ai][bj][m][1] * sc;
                    u32x4 w; w.x = cvt_pk_bf16(v0[0], v0[1]); w.y = cvt_pk_bf16(v0[2], v0[3]); w.z = cvt_pk_bf16(v1[0], v1[1]); w.w = cvt_pk_bf16(v1[2], v1[3]);
                    AT(u32x4, O, off + bj * 256) = w; } }
    }
};

template <int MODE, int WSTATS> struct EpiResid {
    static constexpr bool PERM = true;
    const float* xin; bf16_t* ub; const float* stats_in; float* stats_out; const float* g; const float* b;
    __device__ __forceinline__ void operator()(const AccT& acc, const pg8::Unit& u, int wr, int wc, int fr, int fq) const {
        const int row0 = u.pm * 256 + wr * 64 + fr, col0 = u.pn * 256 + wc * 32 + 8 * fq;
        f32x4 gv[2][2], bv[2][2]; f32x2 sv[8];
        if (MODE == 1) {
#pragma unroll
            for (int k = 0; k < 8; ++k) sv[k] = ATC(f32x2, stats_in, (unsigned)(row0 + (k >> 2) * 128 + (k & 3) * 16) * 8u);
#pragma unroll
            for (int bj = 0; bj < 2; ++bj)
#pragma unroll
                for (int n = 0; n < 2; ++n) { gv[bj][n] = ATC(f32x4, g, (unsigned)(col0 + bj * 128 + 4 * n) * 4u); bv[bj][n] = ATC(f32x4, b, (unsigned)(col0 + bj * 128 + 4 * n) * 4u); }
        }
        u32x4 rwn[2][2];
        if (MODE == 1) {
#pragma unroll
            for (int mm = 0; mm < 2; ++mm)
#pragma unroll
                for (int bj = 0; bj < 2; ++bj) rwn[mm][bj] = ATC(u32x4, ub, ((unsigned)(row0 + mm * 16) * (unsigned)DM + (unsigned)(col0 + bj * 128)) * 2u);
        }
#pragma unroll
        for (int bt = 0; bt < 4; ++bt) {
            const int ai = bt >> 1, mp = bt & 1;
            f32x4 rx[2][2][2]; u32x4 rw[2][2];
            if (MODE == 1) {
#pragma unroll
                for (int mm = 0; mm < 2; ++mm)
#pragma unroll
                    for (int bj = 0; bj < 2; ++bj) rw[mm][bj] = rwn[mm][bj];
                if (bt < 3) {
                    const int ai2 = (bt + 1) >> 1, mp2 = (bt + 1) & 1;
#pragma unroll
                    for (int mm = 0; mm < 2; ++mm)
#pragma unroll
                        for (int bj = 0; bj < 2; ++bj) rwn[mm][bj] = ATC(u32x4, ub, ((unsigned)(row0 + ai2 * 128 + (2 * mp2 + mm) * 16) * (unsigned)DM + (unsigned)(col0 + bj * 128)) * 2u);
                }
            } else {
#pragma unroll
                for (int mm = 0; mm < 2; ++mm)
#pragma unroll
                    for (int bj = 0; bj < 2; ++bj) {
                        const unsigned eoff = (unsigned)(row0 + ai * 128 + (2 * mp + mm) * 16) * (unsigned)DM + (unsigned)(col0 + bj * 128);
                        rx[mm][bj][0] = ATC(f32x4, xin, eoff * 4u); rx[mm][bj][1] = ATC(f32x4, xin, eoff * 4u + 16u);
                    }
            }
#pragma unroll
            for (int mm = 0; mm < 2; ++mm) {
                const int m = 2 * mp + mm, row = row0 + ai * 128 + m * 16;
                float mu = 0.f, rs = 1.f;
                if (MODE == 1) mean_rstd(sv[ai * 4 + m], mu, rs);
                float s1 = 0.f, s2 = 0.f;
#pragma unroll
                for (int bj = 0; bj < 2; ++bj) {
                    f32x4 r0, r1;
                    if (MODE == 1) { const u32x4 wv = rw[mm][bj];
                        r0 = (f32x4){bflo(wv.x), bfhi(wv.x), bflo(wv.y), bfhi(wv.y)}; r1 = (f32x4){bflo(wv.z), bfhi(wv.z), bflo(wv.w), bfhi(wv.w)};
                        r0 = (r0 - mu) * rs * gv[bj][0] + bv[bj][0]; r1 = (r1 - mu) * rs * gv[bj][1] + bv[bj][1]; }
                    else { r0 = rx[mm][bj][0]; r1 = rx[mm][bj][1]; }
                    const f32x4 o0 = r0 * ALPHA + acc[ai][bj][m][0], o1 = r1 * ALPHA + acc[ai][bj][m][1];
                    u32x4 w; w.x = cvt_pk_bf16(o0[0], o0[1]); w.y = cvt_pk_bf16(o0[2], o0[3]); w.z = cvt_pk_bf16(o1[0], o1[1]); w.w = cvt_pk_bf16(o1[2], o1[3]);
                    AT(u32x4, ub, ((unsigned)row * (unsigned)DM + (unsigned)(col0 + bj * 128)) * 2u) = w;
                    if (WSTATS) {
                        s1 += ((o0[0] + o0[1]) + (o0[2] + o0[3])) + ((o1[0] + o1[1]) + (o1[2] + o1[3]));
                        s2 += ((o0[0] * o0[0] + o0[1] * o0[1]) + (o0[2] * o0[2] + o0[3] * o0[3])) + ((o1[0] * o1[0] + o1[1] * o1[1]) + (o1[2] * o1[2] + o1[3] * o1[3])); }
                }
                if (WSTATS) {
                    s1 += __shfl_xor(s1, 16); s2 += __shfl_xor(s2, 16); s1 += __shfl_xor(s1, 32); s2 += __shfl_xor(s2, 32);
                    if (fq == 0) stat_add(stats_out, row, s1, s2); }
            }
        }
    }
};

struct EpiUp {
    static constexpr bool PERM = true;
    bf16_t* O; const float* stats_in; const float* c1; const float* c2;
    __device__ __forceinline__ void operator()(const AccT& acc, const pg8::Unit& u, int wr, int wc, int fr, int fq) const {
        const int row0 = u.pm * 256 + wr * 64 + fr, col0 = u.pn * 256 + wc * 32 + 8 * fq;
        f32x2 sv[8];
#pragma unroll
        for (int k = 0; k < 8; ++k) sv[k] = ATC(f32x2, stats_in, (unsigned)(row0 + (k >> 2) * 128 + (k & 3) * 16) * 8u);
#pragma unroll
        for (int bj = 0; bj < 2; ++bj) {
            const f32x4 c10 = ATC(f32x4, c1, (unsigned)(col0 + bj * 128) * 4u), c11 = ATC(f32x4, c1, (unsigned)(col0 + bj * 128 + 4) * 4u);
            const f32x4 c20 = ATC(f32x4, c2, (unsigned)(col0 + bj * 128) * 4u), c21 = ATC(f32x4, c2, (unsigned)(col0 + bj * 128 + 4) * 4u);
#pragma unroll
            for (int ai = 0; ai < 2; ++ai)
#pragma unroll
                for (int m = 0; m < 4; ++m) {
                    const int row = row0 + ai * 128 + m * 16;
                    float mean, rstd; mean_rstd(sv[ai * 4 + m], mean, rstd);
                    f32x4 v0 = (acc[ai][bj][m][0] - mean * c10) * rstd + c20;
                    f32x4 v1 = (acc[ai][bj][m][1] - mean * c11) * rstd + c21;
#pragma unroll
                    for (int j = 0; j < 4; ++j) { const float a = fmaxf(v0[j], 0.f), c = fmaxf(v1[j], 0.f); v0[j] = a * a; v1[j] = c * c; }
                    u32x4 w; w.x = cvt_pk_bf16(v0[0], v0[1]); w.y = cvt_pk_bf16(v0[2], v0[3]); w.z = cvt_pk_bf16(v1[0], v1[1]); w.w = cvt_pk_bf16(v1[2], v1[3]);
                    AT(u32x4, O, ((unsigned)row * (unsigned)DFF + (unsigned)(col0 + bj * 128)) * 2u) = w;
                }
        }
    }
};

struct EpiProj1 {
    static constexpr bool PERM = true;
    bf16_t* O; float* logf; const float* stats_in; const float* c1; const float* c2; const float* lbin;
    __device__ __forceinline__ void operator()(const AccT& acc, const pg8::Unit& u, int wr, int wc, int fr, int fq) const {
        const int row0 = u.pm * 256 + wr * 64 + fr, col0 = u.pn * 256 + wc * 32 + 8 * fq;
        const int kind = u.pn / 3;
        f32x2 sv[8];
#pragma unroll
        for (int k = 0; k < 8; ++k) sv[k] = ATC(f32x2, stats_in, (unsigned)(row0 + (k >> 2) * 128 + (k & 3) * 16) * 8u);
#pragma unroll
        for (int bj = 0; bj < 2; ++bj) {
            f32x4 c1v[2], c2v[2], lbv[2];
#pragma unroll
            for (int n = 0; n < 2; ++n) { c1v[n] = ATC(f32x4, c1, (unsigned)(col0 + bj * 128 + 4 * n) * 4u); c2v[n] = ATC(f32x4, c2, (unsigned)(col0 + bj * 128 + 4 * n) * 4u); lbv[n] = (f32x4){0.f, 0.f, 0.f, 0.f}; }
            if (kind == 1) {
#pragma unroll
                for (int n = 0; n < 2; ++n) {
                    const unsigned j0 = (unsigned)(col0 - 768 + bj * 128 + 4 * n);
                    const f32x4 l0 = ATC(f32x4, lbin, j0 * 4u), l1 = ATC(f32x4, lbin, (768u + j0) * 4u);
#pragma unroll
                    for (int j = 0; j < 4; ++j) { const float mx = fmaxf(l0[j], l1[j]), e0 = __expf(l0[j] - mx), e1 = __expf(l1[j] - mx), sm = e0 + e1, p0 = e0 / sm, p1 = e1 / sm; lbv[n][j] = (p0 + p1) - p0; }
                }
            }
#pragma unroll
            for (int ai = 0; ai < 2; ++ai)
#pragma unroll
                for (int m = 0; m < 4; ++m) {
                    const int row = row0 + ai * 128 + m * 16;
                    float mean, rstd; mean_rstd(sv[ai * 4 + m], mean, rstd);
                    f32x4 v[2];
                    v[0] = (acc[ai][bj][m][0] - mean * c1v[0]) * rstd + c2v[0];
                    v[1] = (acc[ai][bj][m][1] - mean * c1v[1]) * rstd + c2v[1];
                    if (kind == 1) {
                        const unsigned cf = (unsigned)(col0 - 768 + bj * 128);
                        const unsigned loff = ((cf >> 7) * (unsigned)(T_TOK * 128) + (unsigned)row * 128u + (cf & 127u)) * 4u;
#pragma unroll
                        for (int n = 0; n < 2; ++n) { f32x4 lf;
#pragma unroll
                            for (int j = 0; j < 4; ++j) { const float z = fminf(fmaxf(v[n][j], -80.f), 80.f), t = __expf(-z), sg = 1.0f / (1.0f + t), lb = lbv[n][j];
                                lf[j] = __logf(lb + (1.0f - lb) * sg); v[n][j] = (1.0f - lb) * (t * sg); }
                            AT(f32x4, logf, loff + 16u * n) = lf; }
                    } else if (kind == 3) {
#pragma unroll
                        for (int n = 0; n < 2; ++n)
#pragma unroll
                            for (int j = 0; j < 4; ++j) { const float z = fminf(fmaxf(v[n][j], -80.f), 80.f); v[n][j] = v[n][j] / (1.0f + __expf(-z)); }
                    } else if (kind == 4) { v[0] = v[0] * (0.125f * 1.44269504f); v[1] = v[1] * (0.125f * 1.44269504f); }
                    u32x4 w; w.x = cvt_pk_bf16(v[0][0], v[0][1]); w.y = cvt_pk_bf16(v[0][2], v[0][3]); w.z = cvt_pk_bf16(v[1][0], v[1][1]); w.w = cvt_pk_bf16(v[1][2], v[1][3]);
                    const unsigned cik = (unsigned)(col0 + bj * 128 - kind * 768);
                    const unsigned eoff = (kind < 4) ? (unsigned)kind * (unsigned)(6 * T_TOK * 128) + (cik >> 7) * (unsigned)(T_TOK * 128) + (unsigned)row * 128u + (cik & 127u)
                                                     : 4u * (unsigned)(6 * T_TOK * 128) + (unsigned)row * 256u + cik;
                    AT(u32x4, O, eoff * 2u) = w;
                }
        }
    }
};

#define LDS_WAIT() asm volatile("s_waitcnt lgkmcnt(0)" ::: "memory")
#define LDS_BARRIER() asm volatile("s_waitcnt lgkmcnt(0)\n\ts_barrier" ::: "memory")
__device__ __forceinline__ void p0_transpose_item(const float* W, int K, int N, bf16_t* WT, LAS float* scr, int item, int lane,
                                                  const float* g, const float* b, float* c1, float* c2) {
    const int nblk = N / 32, kb = item / nblk, nb = item % nblk, k0 = 64 * kb, n0 = 32 * nb;
    { f32x4 t[8];
#pragma unroll
      for (int i = 0; i < 8; ++i) t[i] = *(const f32x4*)(W + (size_t)(k0 + 8 * i + (lane >> 3)) * N + n0 + 4 * (lane & 7));
#pragma unroll
      for (int i = 0; i < 8; ++i) { LAS float* d = scr + (8 * i + (lane >> 3)) * 33 + 4 * (lane & 7); d[0] = t[i][0]; d[1] = t[i][1]; d[2] = t[i][2]; d[3] = t[i][3]; } }
    LDS_WAIT(); asm volatile("" ::: "memory");
    const int c = lane & 7;
    float gk[8], bk[8];
#pragma unroll
    for (int e = 0; e < 8; ++e) { gk[e] = g ? g[k0 + 8 * c + e] : 1.f; bk[e] = g ? b[k0 + 8 * c + e] : 0.f; }
#pragma unroll
    for (int j = 0; j < 4; ++j) { const int n = (lane >> 3) + 8 * j; const LAS float* s = scr + (8 * c) * 33 + n;
        float w[8], p2 = 0.f;
#pragma unroll
        for (int e = 0; e < 8; ++e) { const float x = s[e * 33]; w[e] = x * gk[e]; p2 += bk[e] * x; }
        u32x4 o; o.x = cvt_pk_bf16(w[0], w[1]); o.y = cvt_pk_bf16(w[2], w[3]); o.z = cvt_pk_bf16(w[4], w[5]); o.w = cvt_pk_bf16(w[6], w[7]);
        *(u32x4*)(WT + (size_t)(n0 + n) * K + k0 + 8 * c) = o;
        if (g) {
            float p1 = ((bflo(o.x) + bfhi(o.x)) + (bflo(o.y) + bfhi(o.y))) + ((bflo(o.z) + bfhi(o.z)) + (bflo(o.w) + bfhi(o.w)));
            p1 += __shfl_xor(p1, 1); p2 += __shfl_xor(p2, 1); p1 += __shfl_xor(p1, 2); p2 += __shfl_xor(p2, 2); p1 += __shfl_xor(p1, 4); p2 += __shfl_xor(p2, 4);
            if (c == 0) { atomicAdd(c1 + n0 + n, p1); atomicAdd(c2 + n0 + n, p2); }
        }
    }
    LDS_WAIT(); asm volatile("" ::: "memory");
}
__device__ __forceinline__ void row_to_bf16(const float* xrow, bf16_t* orow, int lane) {
    const f32x4* xr = (const f32x4*)xrow + lane; u32x2* o8 = (u32x2*)orow + lane;
#pragma unroll
    for (int j = 0; j < 4; ++j) { const f32x4 v = xr[64 * j]; u32x2 w; w.x = cvt_pk_bf16(v[0], v[1]); w.y = cvt_pk_bf16(v[2], v[3]); o8[64 * j] = w; }
}

struct Args { const float* in[14]; float* out; unsigned char* ws; int ph_lo, ph_hi; };

typedef float f32x16 __attribute__((ext_vector_type(16)));
#define MFMA32(a, b, c) __builtin_amdgcn_mfma_f32_32x32x16_bf16((a), (b), (c), 0, 0, 0)
constexpr int KV_PITCH = 144;
template <int O0, int O1, int O2, int O3>
__device__ __forceinline__ void tr_read4(unsigned addr, u32x2& r0, u32x2& r1, u32x2& r2, u32x2& r3) {
    asm volatile("ds_read_b64_tr_b16 %0, %4 offset:%5\n\tds_read_b64_tr_b16 %1, %4 offset:%6\n\tds_read_b64_tr_b16 %2, %4 offset:%7\n\tds_read_b64_tr_b16 %3, %4 offset:%8\n\ts_waitcnt lgkmcnt(0)"
                 : "=&v"(r0), "=&v"(r1), "=&v"(r2), "=&v"(r3) : "v"(addr), "n"(O0), "n"(O1), "n"(O2), "n"(O3) : "memory");
}
__device__ __forceinline__ bf16x8 pack8(float x0, float x1, float x2, float x3, float x4, float x5, float x6, float x7) {
    u32x4 p;
    asm volatile("v_cvt_pk_bf16_f32 %0, %4, %5\n\tv_cvt_pk_bf16_f32 %1, %6, %7\n\tv_cvt_pk_bf16_f32 %2, %8, %9\n\tv_cvt_pk_bf16_f32 %3, %10, %11\n\ts_nop 1"
                 : "=&v"(p[0]), "=&v"(p[1]), "=&v"(p[2]), "=&v"(p[3]) : "v"(x0), "v"(x1), "v"(x2), "v"(x3), "v"(x4), "v"(x5), "v"(x6), "v"(x7));
    return __builtin_bit_cast(bf16x8, p);
}
__device__ __forceinline__ bf16x8 as_bf16x8(u32x2 lo, u32x2 hi) { u32x4 p; p.x = lo.x; p.y = lo.y; p.z = hi.x; p.w = hi.y; return __builtin_bit_cast(bf16x8, p); }
__device__ __forceinline__ void pv_block(f32x16& o0, f32x16& o1, unsigned vaddr, bf16x8 pf0, bf16x8 pf1) {
    u32x2 a, b, c, d;
    tr_read4<0, 8 * KV_PITCH, 64, 8 * KV_PITCH + 64>(vaddr, a, b, c, d);
    o0 = MFMA32(as_bf16x8(a, b), pf0, o0); o1 = MFMA32(as_bf16x8(c, d), pf0, o1);
    tr_read4<16 * KV_PITCH, 24 * KV_PITCH, 16 * KV_PITCH + 64, 24 * KV_PITCH + 64>(vaddr, a, b, c, d);
    o0 = MFMA32(as_bf16x8(a, b), pf1, o0); o1 = MFMA32(as_bf16x8(c, d), pf1, o1);
}
__device__ __forceinline__ int crow(int i, int hh) { return (i & 3) + 8 * (i >> 2) + 4 * hh; }

struct SbState { f32x16 o0, o1; float C; bool wdone; int it, kt; };
__device__ __forceinline__ bool sb2_iter(LAS unsigned char* lds, SbState& st, u32x4 (&kreg)[2], u32x4 (&vreg)[2], const bf16_t* const (&gk)[2], const unsigned (&st_off)[2],
                                         const bf16x8 (&qf)[4], int w, int lane, int tq0) {
    constexpr int HB_ = 2 * 64 * KV_PITCH, BUF_ = 2 * HB_;
    const int r = lane & 31, hh = lane >> 5, hs = w >> 2, tq = tq0 + r, it = st.it, kt = st.kt;
    LAS unsigned* flags = (LAS unsigned*)(lds + 2 * BUF_);
    LAS unsigned char* buf = lds + (it & 1) * BUF_;
#pragma unroll
    for (int i = 0; i < 2; ++i) { *(LAS u32x4*)(buf + st_off[i]) = kreg[i]; *(LAS u32x4*)(buf + st_off[i] + 64 * KV_PITCH) = vreg[i]; }
    LDS_BARRIER();
    if (it > 0) { bool all = true;
#pragma unroll
        for (int i = 0; i < 8; ++i) all = all && (flags[((it - 1) & 1) * 8 + i] != 0u);
        if (all) return true; }
    if (kt >= 2) {
#pragma unroll
        for (int i = 0; i < 2; ++i) { kreg[i] = *(const u32x4*)(gk[i] + (size_t)(64 * (kt - 2)) * NP0); vreg[i] = *(const u32x4*)(gk[i] + (size_t)(64 * (kt - 2)) * NP0 + 768); } }
    const int k0 = 64 * kt;
    LAS unsigned char* kbuf = buf + hs * HB_; LAS unsigned char* vbuf = kbuf + 64 * KV_PITCH;
    const int i16 = lane & 15, q4 = i16 >> 2, p4 = i16 & 3, blk = (lane >> 4) & 1;
    const unsigned tr_lane = (4 * hh + q4) * KV_PITCH + 32 * blk + 8 * p4;
    float C = st.C;
    if (k0 <= tq0 && !st.wdone) {
        const bool need_mask = (k0 + 64 > tq0);
#pragma unroll
        for (int kbi = 0; kbi < 2; ++kbi) { const int kb = 1 - kbi;
            if (kb == 1 && k0 == tq0) continue;
            f32x16 sT;
#pragma unroll
            for (int i = 0; i < 16; ++i) sT[i] = 0.f;
            const LAS unsigned char* ka = kbuf + (32 * kb + r) * KV_PITCH + 16 * hh;
            { bf16x8 af[4];
#pragma unroll
              for (int s = 0; s < 4; ++s) af[s] = *(const LAS bf16x8*)(ka + 32 * s);
              asm volatile("" ::: "memory");
#pragma unroll
              for (int s = 0; s < 4; ++s) sT = MFMA32(af[s], qf[s], sT); }
            float a[16], be[16];
#pragma unroll
            for (int i = 0; i < 16; ++i) {
                const float z2 = fminf(sT[i], 115.f);
                const float e = __builtin_amdgcn_exp2f(z2), av = __builtin_amdgcn_rcpf(1.0f + e);
                a[i] = av; be[i] = e * av;
            }
            if (need_mask) {
#pragma unroll
                for (int i = 0; i < 16; ++i) { const bool dead = (k0 + 32 * kb + crow(i, hh) >= tq); a[i] = dead ? 1.0f : a[i]; be[i] = dead ? 0.0f : be[i]; }
            }
            float gp[4], pp[4];
#pragma unroll
            for (int g = 0; g < 4; ++g) { gp[g] = (a[4 * g] * a[4 * g + 1]) * (a[4 * g + 2] * a[4 * g + 3]); pp[g] = __shfl_xor(gp[g], 32); }
            float wv[16];
#pragma unroll
            for (int gi = 0; gi < 4; ++gi) { const int g = 3 - gi;
                float P = hh ? C : C * pp[g];
#pragma unroll
                for (int ei = 0; ei < 4; ++ei) { const int i = 4 * g + 3 - ei; wv[i] = be[i] * P; P *= a[i]; }
                C *= gp[g] * pp[g]; }
            const bf16x8 pf0 = pack8(wv[0], wv[1], wv[2], wv[3], wv[4], wv[5], wv[6], wv[7]);
            const bf16x8 pf1 = pack8(wv[8], wv[9], wv[10], wv[11], wv[12], wv[13], wv[14], wv[15]);
            pv_block(st.o0, st.o1, (unsigned)(size_t)(vbuf + 32 * kb * KV_PITCH) + tr_lane, pf0, pf1);
        }
    }
    st.C = C;
    { const bool done = (k0 <= tq0) && (C < 1e-30f);
      const unsigned long long bal = __ballot(done);
      st.wdone = (bal == ~0ull);
      if (lane == 0) flags[(it & 1) * 8 + w] = st.wdone ? 1u : 0u; }
    if (kt == 0) return true;
    st.it = it + 1; st.kt = kt - 1;
    return false;
}
__device__ __forceinline__ void sb_attn_unit2(LAS unsigned char* lds, const bf16_t* proj, bf16_t* mix, int unit) {
    const int tid = threadIdx.x, lane = tid & 63, w = tid >> 6, r = lane & 31, hh = lane >> 5;
    const int qb = unit & 31, hp = (unit >> 5) % 6, bb = unit / 192;
    const int hs = w >> 2, h = 2 * hp + hs;
    const size_t brow = (size_t)bb * SEQ; const int t0 = 128 * qb, tq0 = t0 + 32 * (w & 3), tq = tq0 + r;
    constexpr int HB_ = 2 * 64 * KV_PITCH;
    bf16x8 qf[4];
    { const bf16_t* qp = proj + (brow + tq) * NP0 + h * 64 + 8 * hh;
#pragma unroll
      for (int s = 0; s < 4; ++s) qf[s] = *(const bf16x8*)(qp + 16 * s); }
    SbState st;
#pragma unroll
    for (int i = 0; i < 16; ++i) { st.o0[i] = 0.f; st.o1[i] = 0.f; }
    st.C = 1.0f; st.wdone = false; st.it = 0; st.kt = 2 * qb + 1;
    const bf16_t* gk[2]; unsigned st_off[2];
#pragma unroll
    for (int i = 0; i < 2; ++i) { const int e = tid + 512 * i, s2 = e >> 9, key = (e >> 3) & 63, c = e & 7;
        gk[i] = proj + (brow + key) * NP0 + 768 + (2 * hp + s2) * 64 + 8 * c; st_off[i] = s2 * HB_ + key * KV_PITCH + c * 16; }
    u32x4 kA[2], vA[2], kB[2], vB[2];
#pragma unroll
    for (int i = 0; i < 2; ++i) { kA[i] = *(const u32x4*)(gk[i] + (size_t)(64 * st.kt) * NP0); vA[i] = *(const u32x4*)(gk[i] + (size_t)(64 * st.kt) * NP0 + 768);
        kB[i] = *(const u32x4*)(gk[i] + (size_t)(64 * (st.kt - 1)) * NP0); vB[i] = *(const u32x4*)(gk[i] + (size_t)(64 * (st.kt - 1)) * NP0 + 768); }
    for (;;) {
        if (sb2_iter(lds, st, kA, vA, gk, st_off, qf, w, lane, tq0)) break;
        if (sb2_iter(lds, st, kB, vB, gk, st_off, qf, w, lane, tq0)) break;
    }
    { bf16_t* op = mix + (brow + tq) * DM + h * 64 + 4 * hh;
#pragma unroll
      for (int g = 0; g < 4; ++g) { u32x2 w0, w1; w0.x = cvt_pk_bf16(st.o0[4 * g], st.o0[4 * g + 1]); w0.y = cvt_pk_bf16(st.o0[4 * g + 2], st.o0[4 * g + 3]);
          w1.x = cvt_pk_bf16(st.o1[4 * g], st.o1[4 * g + 1]); w1.y = cvt_pk_bf16(st.o1[4 * g + 2], st.o1[4 * g + 3]);
          *(u32x2*)(op + 8 * g) = w0; *(u32x2*)(op + 32 + 8 * g) = w1; } }
    __syncthreads();
}

__device__ __forceinline__ void mem_attn_unit(LAS unsigned char* lds, const bf16_t* proj, int ldp, int qoff, const bf16_t* kv, bf16_t* mix, int unit) {
    const int tid = threadIdx.x, lane = tid & 63, w = tid >> 6, r = lane & 31, hh = lane >> 5;
    const int qb = unit & 15, hm = (unit >> 4) & 3, bb = unit >> 6;
    const size_t row = (size_t)bb * SEQ + qb * 256 + 32 * w + r;
    LAS unsigned char* kbuf = lds; LAS unsigned char* vbuf = lds + 256 * KV_PITCH;
    { const bf16_t* g = kv + (size_t)bb * 256 * 1024 + hm * 64;
#pragma unroll
      for (int i = 0; i < 4; ++i) { const int e = tid + 512 * i, key = e >> 3, c = e & 7;
          *(LAS u32x4*)(kbuf + key * KV_PITCH + c * 16) = *(const u32x4*)(g + (size_t)key * 1024 + 8 * c);
          *(LAS u32x4*)(vbuf + key * KV_PITCH + c * 16) = *(const u32x4*)(g + (size_t)key * 1024 + 256 + 8 * c); } }
    bf16x8 qf[4];
    { const bf16_t* qp = proj + row * ldp + qoff + hm * 64 + 8 * hh;
#pragma unroll
      for (int s = 0; s < 4; ++s) qf[s] = *(const bf16x8*)(qp + 16 * s); }
    __syncthreads();
    float mx = -3.0e38f;
#pragma unroll 1
    for (int kb = 0; kb < 8; ++kb) {
        f32x16 sT;
#pragma unroll
        for (int i = 0; i < 16; ++i) sT[i] = 0.f;
        const LAS unsigned char* ka = kbuf + (32 * kb + r) * KV_PITCH + 16 * hh;
        { bf16x8 af[4];
#pragma unroll
          for (int s = 0; s < 4; ++s) af[s] = *(const LAS bf16x8*)(ka + 32 * s);
          asm volatile("" ::: "memory");
#pragma unroll
          for (int s = 0; s < 4; ++s) sT = MFMA32(af[s], qf[s], sT); }
#pragma unroll
        for (int i = 0; i < 16; ++i) mx = fmaxf(mx, sT[i]);
    }
    mx = fmaxf(mx, __shfl_xor(mx, 32));
    f32x16 o0, o1;
#pragma unroll
    for (int i = 0; i < 16; ++i) { o0[i] = 0.f; o1[i] = 0.f; }
    float l = 0.f;
    const int i16 = lane & 15, q4 = i16 >> 2, p4 = i16 & 3, blk = (lane >> 4) & 1;
    const unsigned tr_lane = (4 * hh + q4) * KV_PITCH + 32 * blk + 8 * p4;
#pragma unroll 1
    for (int kb = 0; kb < 8; ++kb) {
        f32x16 sT;
#pragma unroll
        for (int i = 0; i < 16; ++i) sT[i] = 0.f;
        const LAS unsigned char* ka = kbuf + (32 * kb + r) * KV_PITCH + 16 * hh;
        { bf16x8 af[4];
#pragma unroll
          for (int s = 0; s < 4; ++s) af[s] = *(const LAS bf16x8*)(ka + 32 * s);
          asm volatile("" ::: "memory");
#pragma unroll
          for (int s = 0; s < 4; ++s) sT = MFMA32(af[s], qf[s], sT); }
        float p[16];
#pragma unroll
        for (int i = 0; i < 16; ++i) { p[i] = __builtin_amdgcn_exp2f(sT[i] - mx); l += p[i]; }
        const bf16x8 pf0 = pack8(p[0], p[1], p[2], p[3], p[4], p[5], p[6], p[7]);
        const bf16x8 pf1 = pack8(p[8], p[9], p[10], p[11], p[12], p[13], p[14], p[15]);
        pv_block(o0, o1, (unsigned)(size_t)(vbuf + 32 * kb * KV_PITCH) + tr_lane, pf0, pf1);
    }
    l += __shfl_xor(l, 32);
    const float il = 1.0f / l;
    { bf16_t* op = mix + row * DM + 768 + hm * 64 + 4 * hh;
#pragma unroll
      for (int g = 0; g < 4; ++g) { u32x2 w0, w1; w0.x = cvt_pk_bf16(o0[4 * g] * il, o0[4 * g + 1] * il); w0.y = cvt_pk_bf16(o0[4 * g + 2] * il, o0[4 * g + 3] * il);
          w1.x = cvt_pk_bf16(o1[4 * g] * il, o1[4 * g + 1] * il); w1.y = cvt_pk_bf16(o1[4 * g + 2] * il, o1[4 * g + 3] * il);
          *(u32x2*)(op + 8 * g) = w0; *(u32x2*)(op + 32 + 8 * g) = w1; } }
    __syncthreads();
}

__device__ __forceinline__ void tr_read8_nat(unsigned addr, u32x2 (&r)[8]) {
    asm volatile("ds_read_b64_tr_b16 %0, %8 offset:0\n\tds_read_b64_tr_b16 %1, %8 offset:1088\n\tds_read_b64_tr_b16 %2, %8 offset:4352\n\tds_read_b64_tr_b16 %3, %8 offset:5440\n\t"
                 "ds_read_b64_tr_b16 %4, %8 offset:8704\n\tds_read_b64_tr_b16 %5, %8 offset:9792\n\tds_read_b64_tr_b16 %6, %8 offset:13056\n\tds_read_b64_tr_b16 %7, %8 offset:14144"
                 : "=&v"(r[0]), "=&v"(r[1]), "=&v"(r[2]), "=&v"(r[3]), "=&v"(r[4]), "=&v"(r[5]), "=&v"(r[6]), "=&v"(r[7]) : "v"(addr) : "memory");
}
__device__ __forceinline__ void tr_read8_perm(unsigned addr, u32x2 (&r)[8]) {
    asm volatile("ds_read_b64_tr_b16 %0, %8 offset:0\n\tds_read_b64_tr_b16 %1, %8 offset:2176\n\tds_read_b64_tr_b16 %2, %8 offset:4352\n\tds_read_b64_tr_b16 %3, %8 offset:6528\n\t"
                 "ds_read_b64_tr_b16 %4, %8 offset:8704\n\tds_read_b64_tr_b16 %5, %8 offset:10880\n\tds_read_b64_tr_b16 %6, %8 offset:13056\n\tds_read_b64_tr_b16 %7, %8 offset:15232"
                 : "=&v"(r[0]), "=&v"(r[1]), "=&v"(r[2]), "=&v"(r[3]), "=&v"(r[4]), "=&v"(r[5]), "=&v"(r[6]), "=&v"(r[7]) : "v"(addr) : "memory");
}
__device__ __forceinline__ void tr_wait8(u32x2 (&a)[8]) {
    asm volatile("s_waitcnt lgkmcnt(0)" : "+v"(a[0]), "+v"(a[1]), "+v"(a[2]), "+v"(a[3]), "+v"(a[4]), "+v"(a[5]), "+v"(a[6]), "+v"(a[7]) :: "memory");
}
__device__ __forceinline__ void tr_wait16(u32x2 (&a)[8], u32x2 (&b)[8]) {
    asm volatile("s_waitcnt lgkmcnt(0)" : "+v"(a[0]), "+v"(a[1]), "+v"(a[2]), "+v"(a[3]), "+v"(a[4]), "+v"(a[5]), "+v"(a[6]), "+v"(a[7]),
                 "+v"(b[0]), "+v"(b[1]), "+v"(b[2]), "+v"(b[3]), "+v"(b[4]), "+v"(b[5]), "+v"(b[6]), "+v"(b[7]) :: "memory");
}
constexpr int HP = 272;
constexpr int HG_NSEG = 16, HG_CPS = 4;
template <int MODE>
__device__ __forceinline__ void hgrn_seg(LAS unsigned char* lds, const bf16_t* proj, const float* logf, const float* gn, bf16_t* mix, float* segs, float* segd, int bh, int seg) {
    const int tid = threadIdx.x, lane = tid & 63, w = tid >> 6, r = lane & 31, hh = lane >> 5;
    const int bb = bh / 6, h = bh % 6; const size_t base = (size_t)bb * SEQ + (size_t)seg * (64 * HG_CPS);
    constexpr size_t KIND_STRIDE = (size_t)6 * T_TOK * 128; const size_t hbase = (size_t)h * T_TOK + base;
    LAS unsigned char* QT = lds; LAS unsigned char* KT = lds + 17408; LAS unsigned char* QG = lds + 34816; LAS unsigned char* VV = lds + 52224; LAS unsigned char* SP = lds + 69632;
    LAS float* GT = (LAS float*)(lds + 104448); LAS float* EGL = (LAS float*)(lds + 108544); LAS float* EGLR = EGL + 128; LAS float* RP = (LAS float*)(lds + 109568);
    LAS float* GNL = (LAS float*)(lds + 110592);
    if (MODE && tid < 128) GNL[tid] = gn[h * 128 + tid];
    const int tb = w >> 2, dvb = w & 3, cp = lane;
    const int i16 = lane & 15, q4 = i16 >> 2, p4 = i16 & 3, blk = (lane >> 4) & 1;
    const unsigned trc = 32 * blk + 8 * p4;
    float* sptr = segs + ((size_t)(bh * HG_NSEG + seg) * 16384) + (size_t)(w * 2) * 1024 + lane;
    f32x16 S0, S1, o;
#pragma unroll
    for (int i = 0; i < 16; ++i) { S0[i] = MODE ? sptr[i * 64] : 0.f; S1[i] = MODE ? sptr[1024 + i * 64] : 0.f; o[i] = 0.f; }
    f32x2 dtot = (f32x2){0.f, 0.f};
    f32x2 gr[8]; unsigned qr[8], kr[8]; u32x4 vr[2]; u32x2 gwr[4];
#define HG_LOAD_G(c) do { const size_t row0 = hbase + 64 * (c) + 8 * w; \
        _Pragma("unroll") for (int i = 0; i < 8; ++i) gr[i] = *(const f32x2*)(logf + (row0 + i) * 128 + 2 * cp); } while (0)
#define HG_LOAD(c) do { const size_t row0 = hbase + 64 * (c) + 8 * w; \
        _Pragma("unroll") for (int i = 0; i < 8; ++i) { \
            const bf16_t* pr = proj + (row0 + i) * 128 + 2 * cp; if (MODE) qr[i] = *(const unsigned*)pr; kr[i] = *(const unsigned*)(pr + KIND_STRIDE); } \
        _Pragma("unroll") for (int i = 0; i < 2; ++i) { const int e = tid + 512 * i; vr[i] = *(const u32x4*)(proj + 2 * KIND_STRIDE + (hbase + 64 * (c) + (e >> 4)) * 128 + 8 * (e & 15)); } } while (0)
#define HG_GATE(c) do { const size_t row = hbase + 64 * (c) + 32 * tb + r; \
        _Pragma("unroll") for (int g = 0; g < 4; ++g) gwr[g] = *(const u32x2*)(proj + 3 * KIND_STRIDE + row * 128 + 32 * dvb + 8 * g + 4 * hh); } while (0)
#define HG_FINAL(c) do { float tot = (RP[(tb * 4 + 0) * 32 + r] + RP[(tb * 4 + 1) * 32 + r]) + (RP[(tb * 4 + 2) * 32 + r] + RP[(tb * 4 + 3) * 32 + r]); \
        const float rs = 1.0f / sqrtf(tot * (1.f / 128.f) + RMS_EPS); const size_t row = base + 64 * (c) + 32 * tb + r; \
        _Pragma("unroll") for (int g = 0; g < 4; ++g) { const int dv0 = h * 128 + 32 * dvb + 8 * g + 4 * hh; \
            const u32x2 gw = gwr[g]; const f32x4 g4 = *(const LAS f32x4*)(GNL + 32 * dvb + 8 * g + 4 * hh); \
            u32x2 ow; ow.x = cvt_pk_bf16(o[4 * g] * rs * g4[0] * bflo(gw.x), o[4 * g + 1] * rs * g4[1] * bfhi(gw.x)); \
            ow.y = cvt_pk_bf16(o[4 * g + 2] * rs * g4[2] * bflo(gw.y), o[4 * g + 3] * rs * g4[3] * bfhi(gw.y)); \
            *(u32x2*)(mix + row * DM + dv0) = ow; } } while (0)
    HG_LOAD_G(0); HG_LOAD(0);
#pragma unroll 1
    for (int c = 0; c < HG_CPS; ++c) {
        f32x2 gl[8]; gl[0] = gr[0];
#pragma unroll
        for (int i = 1; i < 8; ++i) gl[i] = gl[i - 1] + gr[i];
        *(LAS f32x2*)(GT + w * 128 + 2 * cp) = gl[7];
        if (c + 1 < HG_CPS) HG_LOAD_G(c + 1);
        LDS_BARRIER();
        if (MODE && c > 0) HG_FINAL(c - 1);
        f32x2 pre = (f32x2){0.f, 0.f}, ref = pre, tot2 = pre;
#pragma unroll
        for (int j = 0; j < 8; ++j) { const f32x2 t = *(const LAS f32x2*)(GT + j * 128 + 2 * cp); if (j < w) pre += t; if (j < 4) ref += t; tot2 += t; }
        dtot += tot2;
#pragma unroll
        for (int i = 0; i < 8; ++i) {
            const f32x2 G = pre + gl[i];
            const float k0 = bflo(kr[i]), k1 = bfhi(kr[i]);
            const float ek0 = __expf(fminf(ref[0] - G[0], 80.f)), ek1 = __expf(fminf(ref[1] - G[1], 80.f));
            const unsigned off = (8 * w + i) * HP + 4 * cp;
            *(LAS unsigned*)(KT + off) = cvt_pk_bf16(k0 * ek0, k1 * ek1);
            if (MODE) {
                const float q0 = bflo(qr[i]), q1 = bfhi(qr[i]);
                const float eq0 = __expf(fminf(G[0] - ref[0], 80.f)), eq1 = __expf(fminf(G[1] - ref[1], 80.f));
                const float eg0 = __expf(G[0]), eg1 = __expf(G[1]);
                *(LAS unsigned*)(QT + off) = cvt_pk_bf16(q0 * eq0, q1 * eq1);
                *(LAS unsigned*)(QG + off) = cvt_pk_bf16(q0 * eg0, q1 * eg1);
            }
        }
#pragma unroll
        for (int i = 0; i < 2; ++i) { const int e = tid + 512 * i; *(LAS u32x4*)(VV + (e >> 4) * HP + 16 * (e & 15)) = vr[i]; }
        if (w == 0) { *(LAS f32x2*)(EGL + 2 * cp) = (f32x2){__expf(tot2[0]), __expf(tot2[1])}; *(LAS f32x2*)(EGLR + 2 * cp) = (f32x2){__expf(tot2[0] - ref[0]), __expf(tot2[1] - ref[1])}; }
        if (MODE) {
#pragma unroll
            for (int g = 0; g < 4; ++g) {
                u32x2 a, b; a.x = cvt_pk_bf16(S0[4 * g], S0[4 * g + 1]); a.y = cvt_pk_bf16(S0[4 * g + 2], S0[4 * g + 3]); b.x = cvt_pk_bf16(S1[4 * g], S1[4 * g + 1]); b.y = cvt_pk_bf16(S1[4 * g + 2], S1[4 * g + 3]);
                const unsigned off = (32 * dvb + r) * HP + (64 * tb + 8 * g + 4 * hh) * 2;
                *(LAS u32x2*)(SP + off) = a; *(LAS u32x2*)(SP + off + 64) = b;
            }
            HG_GATE(c);
        }
        if (c + 1 < HG_CPS) HG_LOAD(c + 1);
        LDS_BARRIER();
        const unsigned vbase = (unsigned)(size_t)VV + 64 * dvb + trc, kbase = (unsigned)(size_t)KT + trc;
        if (MODE) {
            bf16x8 pf[2][2], qtf[8];
#pragma unroll
            for (int ks = 0; ks < 8; ++ks) qtf[ks] = *(const LAS bf16x8*)(QT + (32 * tb + r) * HP + 32 * ks + 16 * hh);
#pragma unroll
            for (int sb = 0; sb < 2; ++sb) if (sb <= tb) {
                f32x16 aT;
#pragma unroll
                for (int i = 0; i < 16; ++i) aT[i] = 0.f;
                { bf16x8 af[8];
#pragma unroll
                  for (int ks = 0; ks < 8; ++ks) af[ks] = *(const LAS bf16x8*)(KT + (32 * sb + r) * HP + 32 * ks + 16 * hh);
                  asm volatile("" ::: "memory");
#pragma unroll
                  for (int ks = 0; ks < 8; ++ks) aT = MFMA32(af[ks], qtf[ks], aT); }
                if (sb == tb) {
#pragma unroll
                    for (int i = 0; i < 16; ++i) aT[i] = (crow(i, hh) > r) ? 0.f : aT[i];
                }
                pf[sb][0] = pack8(aT[0], aT[1], aT[2], aT[3], aT[4], aT[5], aT[6], aT[7]);
                pf[sb][1] = pack8(aT[8], aT[9], aT[10], aT[11], aT[12], aT[13], aT[14], aT[15]);
            }
#pragma unroll
            for (int i = 0; i < 16; ++i) o[i] = 0.f;
            { bf16x8 af[8], bfr[8];
#pragma unroll
              for (int ks = 0; ks < 8; ++ks) { af[ks] = *(const LAS bf16x8*)(SP + (32 * dvb + r) * HP + 32 * ks + 16 * hh); bfr[ks] = *(const LAS bf16x8*)(QG + (32 * tb + r) * HP + 32 * ks + 16 * hh); }
              asm volatile("" ::: "memory");
#pragma unroll
              for (int ks = 0; ks < 8; ++ks) o = MFMA32(af[ks], bfr[ks], o); }
            { u32x2 vt[8]; tr_read8_perm(vbase + (4 * hh + q4) * HP, vt); tr_wait8(vt);
              o = MFMA32(as_bf16x8(vt[0], vt[1]), pf[0][0], o); o = MFMA32(as_bf16x8(vt[2], vt[3]), pf[0][1], o);
              if (tb) { o = MFMA32(as_bf16x8(vt[4], vt[5]), pf[1][0], o); o = MFMA32(as_bf16x8(vt[6], vt[7]), pf[1][1], o); } }
            float ss = 0.f;
#pragma unroll
            for (int i = 0; i < 16; ++i) ss += o[i] * o[i];
            ss += __shfl_xor(ss, 32);
            if (hh == 0) RP[(tb * 4 + dvb) * 32 + r] = ss;
        }
        if (MODE == 0 || c + 1 < HG_CPS) {
            u32x2 vf[8], kf[8];
            tr_read8_nat(vbase + (8 * hh + q4) * HP, vf);
            tr_read8_nat(kbase + 128 * tb + (8 * hh + q4) * HP, kf);
            tr_wait16(vf, kf);
#pragma unroll
            for (int j = 0; j < 2; ++j) {
                const int kkb = 2 * tb + j;
                f32x16 M;
#pragma unroll
                for (int i = 0; i < 16; ++i) M[i] = 0.f;
                if (j == 1) { tr_read8_nat(kbase + 128 * tb + 64 + (8 * hh + q4) * HP, kf); tr_wait8(kf); }
#pragma unroll
                for (int ks = 0; ks < 4; ++ks) M = MFMA32(as_bf16x8(kf[2 * ks], kf[2 * ks + 1]), as_bf16x8(vf[2 * ks], vf[2 * ks + 1]), M);
#pragma unroll
                for (int g = 0; g < 4; ++g) { const f32x4 el = *(const LAS f32x4*)(EGL + 32 * kkb + 8 * g + 4 * hh), er = *(const LAS f32x4*)(EGLR + 32 * kkb + 8 * g + 4 * hh);
#pragma unroll
                    for (int e = 0; e < 4; ++e) { if (j == 0) S0[4 * g + e] = el[e] * S0[4 * g + e] + er[e] * M[4 * g + e]; else S1[4 * g + e] = el[e] * S1[4 * g + e] + er[e] * M[4 * g + e]; } }
            }
        }
    }
    __syncthreads();
    if (MODE) { HG_FINAL(HG_CPS - 1); }
    else {
#pragma unroll
        for (int i = 0; i < 16; ++i) { sptr[i * 64] = S0[i]; sptr[1024 + i * 64] = S1[i]; }
        if (w == 0) *(f32x2*)(segd + (size_t)(bh * HG_NSEG + seg) * 128 + 2 * cp) = (f32x2){__expf(dtot[0]), __expf(dtot[1])};
    }
    __syncthreads();
#undef HG_LOAD
#undef HG_LOAD_G
#undef HG_GATE
#undef HG_FINAL
}
__device__ __forceinline__ void hgrn_seg_state(LAS unsigned char* lds, const bf16_t* proj, const float* logf, float* segs, float* segd, int bh, int seg) {
    const int tid = threadIdx.x, lane = tid & 63, w = tid >> 6, hh = lane >> 5, cp = lane;
    const int bb = bh / 6, h = bh % 6;
    constexpr size_t KIND_STRIDE = (size_t)6 * T_TOK * 128; const size_t hbase = (size_t)h * T_TOK + (size_t)bb * SEQ + (size_t)seg * 256;
    LAS unsigned char* KD = lds; LAS unsigned char* VV = lds + 69632; LAS float* GT2 = (LAS float*)(lds + 139264);
    const int tb = w >> 2, dvb = w & 3;
    const int i16 = lane & 15, q4 = i16 >> 2, p4 = i16 & 3, blk = (lane >> 4) & 1;
    const unsigned trc = 32 * blk + 8 * p4;
    { u32x4 vr[8];
#pragma unroll
      for (int i = 0; i < 8; ++i) { const int e = tid + 512 * i; vr[i] = *(const u32x4*)(proj + 2 * KIND_STRIDE + (hbase + (e >> 4)) * 128 + 8 * (e & 15)); }
#pragma unroll
      for (int i = 0; i < 8; ++i) { const int e = tid + 512 * i; *(LAS u32x4*)(VV + (e >> 4) * HP + 16 * (e & 15)) = vr[i]; } }
    f32x2 gl[32]; unsigned kr[32];
    { const size_t row0 = hbase + 32 * w;
#pragma unroll
      for (int i = 0; i < 32; ++i) { gl[i] = *(const f32x2*)(logf + (row0 + i) * 128 + 2 * cp); kr[i] = *(const unsigned*)(proj + KIND_STRIDE + (row0 + i) * 128 + 2 * cp); } }
#pragma unroll
    for (int i = 1; i < 32; ++i) gl[i] = gl[i - 1] + gl[i];
    *(LAS f32x2*)(GT2 + w * 128 + 2 * cp) = gl[31];
    __syncthreads();
    f32x2 pre = (f32x2){0.f, 0.f}, tot = pre;
#pragma unroll
    for (int j = 0; j < 8; ++j) { const f32x2 t = *(const LAS f32x2*)(GT2 + j * 128 + 2 * cp); if (j < w) pre += t; tot += t; }
    const f32x2 rem = tot - pre;
#pragma unroll
    for (int i = 0; i < 32; ++i) {
        const f32x2 d = rem - gl[i];
        const float e0 = __expf(fminf(d[0], 0.f)), e1 = __expf(fminf(d[1], 0.f));
        *(LAS unsigned*)(KD + (32 * w + i) * HP + 4 * cp) = cvt_pk_bf16(bflo(kr[i]) * e0, bfhi(kr[i]) * e1);
    }
    if (w == 0) *(f32x2*)(segd + (size_t)(bh * HG_NSEG + seg) * 128 + 2 * cp) = (f32x2){__expf(tot[0]), __expf(tot[1])};
    __syncthreads();
    f32x16 S0, S1;
#pragma unroll
    for (int i = 0; i < 16; ++i) { S0[i] = 0.f; S1[i] = 0.f; }
    const unsigned vbase = (unsigned)(size_t)VV + 64 * dvb + trc + (8 * hh + q4) * HP, kbase = (unsigned)(size_t)KD + trc + 128 * tb + (8 * hh + q4) * HP;
#pragma unroll 1
    for (int q = 0; q < 4; ++q) {
        u32x2 vf[8], kf0[8], kf1[8];
        tr_read8_nat(vbase + q * 64 * HP, vf); tr_read8_nat(kbase + q * 64 * HP, kf0); tr_read8_nat(kbase + q * 64 * HP + 64, kf1);
        tr_wait16(vf, kf0); tr_wait8(kf1);
#pragma unroll
        for (int ks = 0; ks < 4; ++ks) { S0 = MFMA32(as_bf16x8(kf0[2 * ks], kf0[2 * ks + 1]), as_bf16x8(vf[2 * ks], vf[2 * ks + 1]), S0);
                                         S1 = MFMA32(as_bf16x8(kf1[2 * ks], kf1[2 * ks + 1]), as_bf16x8(vf[2 * ks], vf[2 * ks + 1]), S1); }
    }
    float* sptr = segs + ((size_t)(bh * HG_NSEG + seg) * 16384) + (size_t)(w * 2) * 1024 + lane;
#pragma unroll
    for (int i = 0; i < 16; ++i) { sptr[i * 64] = S0[i]; sptr[1024 + i * 64] = S1[i]; }
    __syncthreads();
}

__device__ __forceinline__ void hgrn_scan(float* segs, const float* segd, int gtid, int nthr) {
    for (int e = gtid; e < 48 * 16384; e += nthr) {
        const int bh = e >> 14, idx = e & 16383, wj = idx >> 10, i = (idx >> 6) & 15, ln = idx & 63;
        const int kk = 32 * (2 * (wj >> 3) + (wj & 1)) + crow(i, ln >> 5);
        float sacc = 0.f;
#pragma unroll 4
        for (int sg = 0; sg < HG_NSEG; ++sg) {
            float* p = segs + (size_t)(bh * HG_NSEG + sg) * 16384 + idx;
            const float L = (sg < HG_NSEG - 1) ? *p : 0.f, d = (sg < HG_NSEG - 1) ? segd[(bh * HG_NSEG + sg) * 128 + kk] : 0.f;
            *p = sacc; sacc = d * sacc + L;
        }
    }
}

#define XB_TMO      128
#define XB_XCNT(j)  (256  + 64 * (j))
#define XB_XSUB(j)  (1280 + 64 * (j))
#define XB_XGEN(j)  (2304 + 64 * (j))
#define XB_TOP      3328
#define XB_TOPGEN   3392
#define XCD_BAR_WORDS 3456
#define XB_SPIN_CAP (1u << 18)
__device__ __forceinline__ unsigned xb_ld(unsigned* p)              { return __hip_atomic_load(p, __ATOMIC_RELAXED, __HIP_MEMORY_SCOPE_AGENT); }
__device__ __forceinline__ unsigned xb_add(unsigned* p, unsigned v) { return __hip_atomic_fetch_add(p, v, __ATOMIC_RELAXED, __HIP_MEMORY_SCOPE_AGENT); }
__device__ __forceinline__ unsigned xb_xcc_id() { return (unsigned)__builtin_amdgcn_s_getreg((3 << 11) | 20) & 0xFu; }
#define XB_SPIN(cond, bar) do { unsigned _sp = 0; while (cond) { __builtin_amdgcn_s_sleep(1); \
    if ((++_sp & 255u) == 0u) { if (xb_ld(&(bar)[XB_TMO])) break; if (_sp > XB_SPIN_CAP) { atomicAdd(&(bar)[XB_TMO], 1u); break; } } } } while (0)
struct XcdBarrier { unsigned* bar; unsigned x; volatile LAS unsigned* st; };
__device__ __forceinline__ XcdBarrier xcd_barrier_post(unsigned* bar, volatile LAS unsigned* st) {
    XcdBarrier b; b.bar = bar; b.x = xb_xcc_id(); b.st = st;
    if (threadIdx.x == 0) (void)xb_add(&bar[XB_XCNT(b.x)], 1u);
    return b;
}
__device__ __forceinline__ void xcd_barrier_complete(unsigned* bar, unsigned x, unsigned& nloc, unsigned& nx) {
    const unsigned G = gridDim.x * gridDim.y * gridDim.z;
    unsigned sum, cnt, mine, sp = 0u;
    for (;;) {
        sum = 0u; cnt = 0u; mine = 0u;
#pragma unroll
        for (unsigned j = 0; j < 16; ++j) { const unsigned c = xb_ld(&bar[XB_XCNT(j)]); sum += c; cnt += (c > 0u) ? 1u : 0u; mine = (j == x) ? c : mine; }
        if (sum == G) break;
        __builtin_amdgcn_s_sleep(1);
        if ((++sp & 255u) == 0u) { if (xb_ld(&bar[XB_TMO])) break; if (sp > XB_SPIN_CAP) { atomicAdd(&bar[XB_TMO], 1u); break; } }
    }
    nloc = mine > 0u ? mine : 1u; nx = cnt > 0u ? cnt : 1u;
}
__device__ __forceinline__ void xcd_barrier(const XcdBarrier& b) {
    asm volatile("s_waitcnt vmcnt(0)" ::: "memory");
    __syncthreads();
    if (threadIdx.x == 0) {
        unsigned* bar = b.bar;
        __builtin_amdgcn_s_waitcnt(0);
        unsigned nloc = b.st[0], nx = b.st[1];
        if (nloc == 0u) { xcd_barrier_complete(bar, b.x, nloc, nx); b.st[0] = nloc; b.st[1] = nx; }
        const unsigned old = xb_add(&bar[XB_XSUB(b.x)], 1u);
        const unsigned gen = old / nloc;
        if (old + 1u == (gen + 1u) * nloc) {
            __builtin_amdgcn_fence(__ATOMIC_RELEASE, "agent");
            asm volatile("s_waitcnt vmcnt(0)" ::: "memory");
            const unsigned og = xb_add(&bar[XB_TOP], 1u);
            const unsigned tg = og / nx;
            if (og + 1u == (tg + 1u) * nx) xb_add(&bar[XB_TOPGEN], 1u);
            else XB_SPIN(xb_ld(&bar[XB_TOPGEN]) == tg, bar);
            __builtin_amdgcn_fence(__ATOMIC_ACQUIRE, "agent");
            xb_add(&bar[XB_XGEN(b.x)], 1u);
            asm volatile("s_waitcnt vmcnt(0)" ::: "memory");
        } else {
            XB_SPIN(xb_ld(&bar[XB_XGEN(b.x)]) == gen, bar);
            __builtin_amdgcn_fence(__ATOMIC_ACQUIRE, "agent");
            asm volatile("s_waitcnt vmcnt(0)" ::: "memory");
        }
    }
    __syncthreads();
}
constexpr size_t OFF_BAR = 98304;

__global__ void __launch_bounds__(512, 2) fwd_kernel(Args args) {
    extern __shared__ __attribute__((aligned(16))) unsigned char lds_raw[];
    LAS unsigned char* lds = (LAS unsigned char*)lds_raw;
    cg::grid_group grid = cg::this_grid();
    const int tid = threadIdx.x, lane = tid & 63, wave = __builtin_amdgcn_readfirstlane(tid >> 6);
    const int G = gridDim.x, bx = blockIdx.x;
    unsigned char* ws = args.ws;
    const float* x = args.in[0]; const float* mem = args.in[1]; const float* w_in_sb = args.in[2]; const float* w_in_hg = args.in[3]; const float* w_mem_kv = args.in[4];
    const float* lower_bounds = args.in[5]; const float* hg_norm_g = args.in[6]; const float* w_out = args.in[7]; const float* ln_mix_g = args.in[8]; const float* ln_mix_b = args.in[9];
    const float* w_up = args.in[10]; const float* w_down = args.in[11]; const float* ln_ffn_g = args.in[12]; const float* ln_ffn_b = args.in[13];
    float* out = args.out;
    bf16_t* WSB = (bf16_t*)(ws + WS_WSB); bf16_t* WHG = (bf16_t*)(ws + WS_WHG); bf16_t* WKV = (bf16_t*)(ws + WS_WKV); bf16_t* WOUT = (bf16_t*)(ws + WS_WOUT);
    bf16_t* WUP = (bf16_t*)(ws + WS_WUP); bf16_t* WDN = (bf16_t*)(ws + WS_WDN); bf16_t* MEMB = (bf16_t*)(ws + WS_MEMB); bf16_t* MEMKV = (bf16_t*)(ws + WS_MEMKV);
    float* ST1 = (float*)(ws + OFF_ST1); float* ST2 = (float*)(ws + OFF_ST2); float* ST3 = (float*)(ws + OFF_ST3);
    bf16_t* UB = (bf16_t*)(ws + WS_UB); bf16_t* MIX = (bf16_t*)(ws + WS_MIX); bf16_t* PROJ = (bf16_t*)(ws + WS_PROJ); float* LOGF = (float*)(ws + WS_LOGF); bf16_t* HB = (bf16_t*)(ws + WS_H);
    float* C1HG = (float*)(ws + OFF_C1HG); float* C2HG = (float*)(ws + OFF_C2HG); float* C1UP0 = (float*)(ws + OFF_C1UP0); float* C2UP0 = (float*)(ws + OFF_C2UP0);
    float* C1UP1 = (float*)(ws + OFF_C1UP1); float* C2UP1 = (float*)(ws + OFF_C2UP1);
    const int lo = args.ph_lo, hi = args.ph_hi;
    volatile LAS unsigned* bst = (volatile LAS unsigned*)(lds + 147392);
    if (tid < 2) bst[tid] = 0u;
    __syncthreads();
    const XcdBarrier gbar = xcd_barrier_post((unsigned*)(ws + OFF_BAR), bst);
    if (lo < 0) grid.sync();
#define GRID_SYNC() xcd_barrier(gbar)
#define IN(k) (lo <= (k) && (k) < hi)
#define SEAM(k) do { if (IN(k) && IN((k) + 1)) GRID_SYNC(); } while (0)
    const int gtid = bx * 512 + tid, nthr = G * 512;

    if (IN(0)) {
        LAS float* scr = (LAS float*)(lds + wave * 16384);
        const int gw = bx * 8 + wave, NGW = G * 8;
        constexpr int I_SB = 16 * (NP0 / 32), I_HG = 16 * (NP1 / 32), I_KV = 16 * (512 / 32), I_OUT = 16 * (1024 / 32), I_UP = 16 * (4096 / 32), I_DN = 64 * (1024 / 32);
                constexpr int N_EARLY = I_SB + 2 * I_KV;
        for (int it = gw; it < N_EARLY; it += NGW) {
            int r = it;
            if (r < I_SB) { p0_transpose_item(w_in_sb, 1024, NP0, WSB, scr, r, lane, nullptr, nullptr, nullptr, nullptr); continue; } r -= I_SB;
            if (r < I_KV) { p0_transpose_item(w_mem_kv, 1024, 512, WKV, scr, r, lane, nullptr, nullptr, nullptr, nullptr); continue; } r -= I_KV;
            p0_transpose_item(w_mem_kv + 1024 * 512, 1024, 512, WKV + 512 * 1024, scr, r, lane, nullptr, nullptr, nullptr, nullptr);
        }
        for (int m = gw; m < T_TOK; m += NGW) row_to_bf16(x + (size_t)m * DM, UB + (size_t)m * DM, lane);
        for (int m = gw; m < 2048; m += NGW) row_to_bf16(mem + (size_t)m * DM, MEMB + (size_t)m * DM, lane);
        __syncthreads();
    }
    SEAM(0);
    if (IN(1)) {
        { pg8::Gemm g{UB, WSB, T_TOK, NP0, 1024}; pg8::StaticOrder S; S.init(T_TOK, NP0, G, bx); EpiBf16Plain E{PROJ, NP0, 0x207u, (0.125f * 1.44269504f)}; pg8::gemm_phase(lds, g, S, E); }
        if (bx < 32 || G <= 64) { pg8::Gemm g{MEMB, WKV, 2048, 1024, 1024}; pg8::StaticOrder S; S.init(2048, 1024, G, bx); EpiBf16Plain E{MEMKV, 1024, 0u, 1.0f}; pg8::gemm_phase(lds, g, S, E); }
        if (bx >= 32 || G <= 64) {
            LAS float* scr = (LAS float*)(lds + wave * 16384);
            const int nb0 = (G <= 64) ? 0 : 32, gw = (bx - nb0) * 8 + wave, NGW = (G - nb0) * 8;
            constexpr int I_HG = 16 * (NP1 / 32), I_OUT = 16 * (1024 / 32), I_UP = 16 * (4096 / 32), I_DN = 64 * (1024 / 32);
            constexpr int N_LATE = I_HG + 2 * I_OUT + 2 * I_UP + 2 * I_DN;
            for (int it = gw; it < N_LATE; it += NGW) {
                int r = it;
                if (r < I_HG) { p0_transpose_item(w_in_hg, 1024, NP1, WHG, scr, r, lane, ln_ffn_g, ln_ffn_b, C1HG, C2HG); continue; } r -= I_HG;
                if (r < I_OUT) { p0_transpose_item(w_out, 1024, 1024, WOUT, scr, r, lane, nullptr, nullptr, nullptr, nullptr); continue; } r -= I_OUT;
                if (r < I_OUT) { p0_transpose_item(w_out + 1024 * 1024, 1024, 1024, WOUT + 1024 * 1024, scr, r, lane, nullptr, nullptr, nullptr, nullptr); continue; } r -= I_OUT;
                if (r < I_UP) { p0_transpose_item(w_up, 1024, 4096, WUP, scr, r, lane, ln_mix_g, ln_mix_b, C1UP0, C2UP0); continue; } r -= I_UP;
                if (r < I_UP) { p0_transpose_item(w_up + 1024 * 4096, 1024, 4096, WUP + 4096 * 1024, scr, r, lane, ln_mix_g + 1024, ln_mix_b + 1024, C1UP1, C2UP1); continue; } r -= I_UP;
                if (r < I_DN) { p0_transpose_item(w_down, 4096, 1024, WDN, scr, r, lane, nullptr, nullptr, nullptr, nullptr); continue; } r -= I_DN;
                p0_transpose_item(w_down + 4096 * 1024, 4096, 1024, WDN + 1024 * 4096, scr, r, lane, nullptr, nullptr, nullptr, nullptr);
            }
            __syncthreads();
        }
    }
    SEAM(1);
    if (IN(2)) {
        for (int u = bx; u < 8 * 6 * 32; u += G) sb_attn_unit2(lds, PROJ, MIX, u);
        for (int u = bx; u < 512; u += G) mem_attn_unit(lds, PROJ, NP0, 2304, MEMKV, MIX, u);
    }
    SEAM(2);
    if (IN(3)) { pg8::Gemm g{MIX, WOUT, T_TOK, 1024, 1024}; pg8::StaticOrder S; S.init(T_TOK, 1024, G, bx);
        EpiResid<0, 1> E{x, UB, nullptr, ST1, nullptr, nullptr}; pg8::gemm_phase(lds, g, S, E); }
    SEAM(3);
    if (IN(4)) { pg8::Gemm g{UB, WUP, T_TOK, 4096, 1024}; pg8::StaticOrder S; S.init(T_TOK, 4096, G, bx);
        EpiUp E{HB, ST1, C1UP0, C2UP0}; pg8::gemm_phase(lds, g, S, E); }
    SEAM(4);
    if (IN(5)) { pg8::Gemm g{HB, WDN, T_TOK, 1024, 4096}; pg8::StaticOrder S; S.init(T_TOK, 1024, G, bx);
        EpiResid<1, 1> E{nullptr, UB, ST1, ST2, ln_mix_g, ln_mix_b}; pg8::gemm_phase(lds, g, S, E); }
    SEAM(5);
    if (IN(6)) { pg8::Gemm g{UB, WHG, T_TOK, NP1, 1024}; pg8::StaticOrder S; S.init(T_TOK, NP1, G, bx);
        EpiProj1 E{PROJ, LOGF, ST2, C1HG, C2HG, lower_bounds}; pg8::gemm_phase(lds, g, S, E); }
    SEAM(6);
    if (IN(7)) {
        float* SEGS = out; float* SEGD = out + (size_t)768 * 16384;
        for (int u = bx; u < 720 + 512; u += G) {
            if (u < 720) hgrn_seg_state(lds, PROJ, LOGF, SEGS, SEGD, u / 15, u % 15);
            else mem_attn_unit(lds, PROJ + (size_t)4 * 6 * T_TOK * 128, 256, 0, MEMKV + 512, MIX, u - 720);
        }
        GRID_SYNC();
        hgrn_scan(SEGS, SEGD, gtid, nthr);
        GRID_SYNC();
        for (int u = bx; u < 768; u += G) hgrn_seg<1>(lds, PROJ, LOGF, hg_norm_g, MIX, SEGS, SEGD, u >> 4, u & 15);
    }
    SEAM(7);
    if (IN(8)) { pg8::Gemm g{MIX, WOUT + 1024 * 1024, T_TOK, 1024, 1024}; pg8::StaticOrder S; S.init(T_TOK, 1024, G, bx);
        EpiResid<1, 1> E{nullptr, UB, ST2, ST3, ln_ffn_g, ln_ffn_b}; pg8::gemm_phase(lds, g, S, E); }
    SEAM(8);
    if (IN(9)) { pg8::Gemm g{UB, WUP + 4096 * 1024, T_TOK, 4096, 1024}; pg8::StaticOrder S; S.init(T_TOK, 4096, G, bx);
        EpiUp E{HB, ST3, C1UP1, C2UP1}; pg8::gemm_phase(lds, g, S, E); }
    SEAM(9);
    if (IN(10)) { pg8::Gemm g{HB, WDN + 1024 * 4096, T_TOK, 1024, 4096}; pg8::StaticOrder S; S.init(T_TOK, 1024, G, bx);
        EpiResid<1, 0> E{nullptr, UB, ST3, nullptr, ln_mix_g + 1024, ln_mix_b + 1024}; pg8::gemm_phase(lds, g, S, E); }
    SEAM(10);
    if (IN(11)) {
        const int gw = bx * 8 + wave, NGW = G * 8;
        const float* gg = ln_ffn_g + 1024; const float* bb = ln_ffn_b + 1024;
        for (int m = gw; m < T_TOK; m += NGW) {
            const u32x4* ur = (const u32x4*)(UB + (size_t)m * DM) + lane;
            f32x4 v[4]; float s = 0.f;
#pragma unroll
            for (int j = 0; j < 2; ++j) { const u32x4 wv = ur[64 * j];
                v[2 * j] = (f32x4){bflo(wv.x), bfhi(wv.x), bflo(wv.y), bfhi(wv.y)}; v[2 * j + 1] = (f32x4){bflo(wv.z), bfhi(wv.z), bflo(wv.w), bfhi(wv.w)}; }
#pragma unroll
            for (int j = 0; j < 4; ++j) s += (v[j][0] + v[j][1]) + (v[j][2] + v[j][3]);
            const float mean = wave_sum(s) * (1.f / DM); float s2 = 0.f;
#pragma unroll
            for (int j = 0; j < 4; ++j) { v[j] = v[j] - mean; s2 += (v[j][0] * v[j][0] + v[j][1] * v[j][1]) + (v[j][2] * v[j][2] + v[j][3] * v[j][3]); }
            const float rstd = 1.f / sqrtf(wave_sum(s2) * (1.f / DM) + LN_EPS);
#pragma unroll
            for (int j = 0; j < 4; ++j) { const int col = 512 * (j >> 1) + 8 * lane + 4 * (j & 1);
                const f32x4 g4 = *(const f32x4*)(gg + col), b4 = *(const f32x4*)(bb + col); *(f32x4*)(out + (size_t)m * DM + col) = v[j] * rstd * g4 + b4; }
        }
    }
#undef IN
#undef SEAM
}

constexpr int N_PHASES = 12;
extern "C" void kernel_launch(void* const* d_in, const int* in_sizes, int n_in, void* d_out, int out_size, void* d_ws, size_t ws_size, hipStream_t stream) {
    static int grid = 0;
    if (grid == 0) {
        if (n_in != 14 || in_sizes[0] != T_TOK * DM || out_size != T_TOK * DM || ws_size < WS_END) { fprintf(stderr, "kernel_launch: unexpected shapes (n_in %d, ws %zu)\n", n_in, ws_size); grid = -1; return; }
        int dev = 0, cus = 0, per_cu = 0;
        hipGetDevice(&dev); hipDeviceGetAttribute(&cus, hipDeviceAttributeMultiprocessorCount, dev);
        if (hipFuncSetAttribute((const void*)fwd_kernel, hipFuncAttributeMaxDynamicSharedMemorySize, LDS_BYTES) != hipSuccess) { fprintf(stderr, "kernel_launch: hipFuncSetAttribute failed\n"); grid = -1; return; }
        if (hipOccupancyMaxActiveBlocksPerMultiprocessor(&per_cu, (const void*)fwd_kernel, 512, LDS_BYTES) != hipSuccess || per_cu < 1) { fprintf(stderr, "kernel_launch: occupancy query says %d\n", per_cu); per_cu = 1; }
        (void)hipGetLastError();
        grid = cus * 1;
    }
    if (grid < 0) return;
    hipMemsetAsync((char*)d_ws + WS_CTL, 0, CTL_ZERO_BYTES, stream);
    Args a{};
    for (int i = 0; i < 14; ++i) a.in[i] = (const float*)d_in[i];
    a.out = (float*)d_out; a.ws = (unsigned char*)d_ws;
    a.ph_lo = 0; a.ph_hi = N_PHASES;
    void* kargs[] = {&a};
    hipError_t e = hipLaunchCooperativeKernel((const void*)fwd_kernel, dim3(grid), dim3(512), kargs, LDS_BYTES, stream);
    if (e != hipSuccess) fprintf(stderr, "cooperative launch failed: %s (grid %d)\n", hipGetErrorString(e), grid);
}
```
